# Optimizing an MI355X kernel written in HIP

```python
import jax, jax.numpy as jnp
from jax import lax
import numpy as np

D_MODEL = 1024
BATCH = 16
SEQ = 4096
DEPTH = 2

CTX_LEN = 256
GRID_W = 64
HEAD_DIM = 64
N_HEADS = D_MODEL // HEAD_DIM
A_GROUPS = N_HEADS // 4
B_HEADS = (N_HEADS - A_GROUPS) // 2
C_HEADS = N_HEADS - A_GROUPS - B_HEADS
A_WIDTH = A_GROUPS * HEAD_DIM
B_WIDTH = B_HEADS * HEAD_DIM
C_WIDTH = C_HEADS * HEAD_DIM
MIX_WIDTH = A_WIDTH + B_WIDTH + C_WIDTH
A_CHUNK = 128
WIN_ROWS = 8
WIN_COLS = 16
C_CHUNK = 64
C_CONV = 3
D_FF = ((8 * D_MODEL + 3 * 256 - 1) // (3 * 256)) * 256
N_MOD = 6
ROPE_BASE = 10000.0
EPS = 1e-6
SPLITS = (A_WIDTH, A_WIDTH,
          B_WIDTH, B_WIDTH, B_WIDTH,
          C_WIDTH, C_WIDTH, C_WIDTH, C_WIDTH,
          4 * C_HEADS)
IN_COLS = sum(SPLITS)

kernel_name = 'hybrid_gmlp_natten_mlstm_dit_block'


def rms_norm(x, g):
    xf = x.astype(jnp.float32)
    y = xf * lax.rsqrt(jnp.mean(xf * xf, axis=-1, keepdims=True) + EPS)
    return (y * g.astype(jnp.float32)).astype(x.dtype)


def layer_norm(x, g, b):
    xf = x.astype(jnp.float32)
    mu = jnp.mean(xf, axis=-1, keepdims=True)
    var = jnp.mean(jnp.square(xf - mu), axis=-1, keepdims=True)
    y = (xf - mu) * lax.rsqrt(var + EPS)
    return (y * g.astype(jnp.float32) + b.astype(jnp.float32)).astype(x.dtype)


def modulate(x, g, shift, scale):
    return rms_norm(x, g) * (1 + scale) + shift


def split_cols(z):
    return jnp.split(z, np.cumsum(SPLITS)[:-1].tolist(), axis=-1)


def to_heads(z, n_heads):
    b_, n, _ = z.shape
    return z.reshape(b_, n, n_heads, HEAD_DIM).transpose(0, 2, 1, 3)


def from_heads(h):
    b_, h_, n, dh = h.shape
    return h.transpose(0, 2, 1, 3).reshape(b_, n, h_ * dh)


def swiglu(h, w_gate, w_up, w_down):
    return (jax.nn.silu(h @ w_gate) * (h @ w_up)) @ w_down


def chunk_token_mlp(z_u, z_v, ln_g, ln_b, ws, bs):
    b_, n, _ = z_u.shape
    u = jax.nn.gelu(z_u).reshape(b_, n, A_GROUPS, HEAD_DIM)
    v = layer_norm(jax.nn.gelu(z_v).reshape(b_, n, A_GROUPS, HEAD_DIM), ln_g, ln_b)
    v = v.reshape(b_, n // A_CHUNK, A_CHUNK, A_GROUPS, HEAD_DIM)
    s = jnp.einsum('gpq,bcqgd->bcpgd', ws, v) + bs.T[:, :, None]
    return (u * s.reshape(b_, n, A_GROUPS, HEAD_DIM)).reshape(b_, n, A_WIDTH)


def neighbourhood_attention(q, k, v, k_ctx, v_ctx, rpb):
    b_, h_, n, dh = q.shape
    rows = n // GRID_W
    kr = min(WIN_ROWS, rows)
    win = kr * WIN_COLS
    scale = dh ** -0.5
    col = jnp.arange(GRID_W)
    key_col = jnp.clip(col - WIN_COLS // 2, 0, GRID_W - WIN_COLS)[:, None] + jnp.arange(WIN_COLS)
    dc = key_col - col[:, None]
    q_rows = q.reshape(b_, h_, rows, GRID_W, dh).transpose(2, 0, 1, 3, 4)

    def row_block(args):
        r, q_blk = args
        key_row = jnp.clip(r - kr // 2, 0, rows - kr) + jnp.arange(kr)
        idx = (key_row[None, :, None] * GRID_W + key_col[:, None, :]).reshape(GRID_W, win)
        k_win = jnp.take(k, idx, axis=2)
        v_win = jnp.take(v, idx, axis=2)
        bias = rpb[:, (key_row - r)[None, :, None] + WIN_ROWS - 1,
                   dc[:, None, :] + WIN_COLS - 1].reshape(h_, GRID_W, win)
        s_win = jnp.einsum('bhqd,bhqkd->bhqk', q_blk, k_win).astype(jnp.float32) * scale + bias.astype(jnp.float32)
        s_ctx = jnp.einsum('bhqd,bhkd->bhqk', q_blk, k_ctx).astype(jnp.float32) * scale
        p = jax.nn.softmax(jnp.concatenate([s_win, s_ctx], axis=-1), axis=-1).astype(v.dtype)
        return (jnp.einsum('bhqk,bhqkd->bhqd', p[..., :win], v_win)
                + jnp.einsum('bhqk,bhkd->bhqd', p[..., win:], v_ctx))

    out = lax.map(row_block, (jnp.arange(rows), q_rows))
    return out.transpose(1, 2, 0, 3, 4).reshape(b_, h_, n, dh)


def context_attention(q, k, v):
    s = jnp.einsum('bhqd,bhkd->bhqk', q, k).astype(jnp.float32) * (q.shape[-1] ** -0.5)
    p = jax.nn.softmax(s, axis=-1).astype(v.dtype)
    return jnp.einsum('bhqk,bhkd->bhqd', p, v)


def axial_rope(x):
    n = x.shape[1]
    t = jnp.arange(n)
    half = HEAD_DIM // 2
    quarter = half // 2
    inv_freq = ROPE_BASE ** (-jnp.arange(quarter, dtype=jnp.float32) / quarter)

    def rotate(xa, pos):
        ang = pos.astype(jnp.float32)[:, None] * inv_freq
        cos = jnp.cos(ang)[None, :, None, :]
        sin = jnp.sin(ang)[None, :, None, :]
        x1 = xa[..., :quarter].astype(jnp.float32)
        x2 = xa[..., quarter:].astype(jnp.float32)
        return jnp.concatenate([x1 * cos - x2 * sin, x1 * sin + x2 * cos], axis=-1)

    out = jnp.concatenate([rotate(x[..., :half], t // GRID_W), rotate(x[..., half:], t % GRID_W)], axis=-1)
    return out.astype(x.dtype)


def centred_dwconv(x, w, b):
    pad = (C_CONV - 1) // 2
    y = lax.conv_general_dilated(x, w[:, None, :].astype(x.dtype), (1,), [(pad, C_CONV - 1 - pad)],
                                 dimension_numbers=('NWC', 'WIO', 'NWC'), feature_group_count=x.shape[-1])
    return y + b


def mlstm_inputs(zq, zk, zv, zg, conv_w, conv_b, gate_b, with_rope):
    b_, n, _ = zq.shape
    qk = jax.nn.silu(centred_dwconv(jnp.concatenate([zq, zk], axis=-1), conv_w, conv_b))
    q = qk[..., :C_WIDTH].reshape(b_, n, C_HEADS, HEAD_DIM)
    k = qk[..., C_WIDTH:].reshape(b_, n, C_HEADS, HEAD_DIM)
    if with_rope:
        q, k = axial_rope(q), axial_rope(k)
    heads = lambda a: a.transpose(0, 2, 1, 3).astype(jnp.float32)
    g = (zg.reshape(b_, n, 4, C_HEADS).astype(jnp.float32) + gate_b.astype(jnp.float32)).transpose(2, 0, 3, 1)
    fwd = (g[0], jax.nn.log_sigmoid(g[1]))
    bwd = (g[2], jax.nn.log_sigmoid(g[3]))
    v = zv.reshape(b_, n, C_HEADS, HEAD_DIM)
    return heads(q), heads(k) * (HEAD_DIM ** -0.5), heads(v), fwd, bwd


def mlstm_chunk_scan(q, k, v, log_i, log_f, state):
    b_, h_, n, dh = q.shape
    nc = n // C_CHUNK

    def chunks(a):
        return jnp.moveaxis(a.reshape(a.shape[:2] + (nc, C_CHUNK) + a.shape[3:]), 2, 0)

    scan_order = jnp.tril(jnp.ones((C_CHUNK, C_CHUNK), dtype=bool))

    def step(carry, inp):
        c_st, n_st, m_st = carry
        qb, kb, vb, ib, fb = inp
        fcum = jnp.cumsum(fb, axis=-1)
        log_inter = fcum + m_st[..., None]
        log_intra = jnp.where(scan_order, fcum[..., :, None] - fcum[..., None, :] + ib[..., None, :], -jnp.inf)
        m_t = jnp.maximum(log_inter, jnp.max(log_intra, axis=-1))
        w_inter = jnp.exp(log_inter - m_t)
        s = jnp.einsum('bhtd,bhsd->bhts', qb, kb) * jnp.exp(log_intra - m_t[..., None])
        num = w_inter[..., None] * jnp.einsum('bhtk,bhkv->bhtv', qb, c_st) + jnp.einsum('bhts,bhsv->bhtv', s, vb)
        den = w_inter * jnp.einsum('bhtk,bhk->bht', qb, n_st) + jnp.sum(s, axis=-1)
        h = num / jnp.maximum(jnp.abs(den), jnp.exp(-m_t))[..., None]
        log_w = fcum[..., -1:] - fcum + ib
        m_new = jnp.maximum(fcum[..., -1] + m_st, jnp.max(log_w, axis=-1))
        a_prev = jnp.exp(fcum[..., -1] + m_st - m_new)
        a_s = jnp.exp(log_w - m_new[..., None])
        c_new = a_prev[..., None, None] * c_st + jnp.einsum('bhs,bhsk,bhsv->bhkv', a_s, kb, vb)
        n_new = a_prev[..., None] * n_st + jnp.einsum('bhs,bhsk->bhk', a_s, kb)
        return (c_new, n_new, m_new), h

    state, hs = lax.scan(step, state, tuple(chunks(a) for a in (q, k, v, log_i, log_f)))
    return jnp.moveaxis(hs, 0, 2).reshape(b_, h_, n, dh), state


def mlstm_final_state(k, v, log_i, log_f):
    fcum = jnp.cumsum(log_f, axis=-1)
    log_w = fcum[..., -1:] - fcum + log_i
    m = jnp.maximum(fcum[..., -1], jnp.max(log_w, axis=-1))
    a = jnp.exp(log_w - m[..., None])
    return (jnp.einsum('bhs,bhsk,bhsv->bhkv', a, k, v), jnp.einsum('bhs,bhsk->bhk', a, k), m)


def mlstm_bidirectional(lat, ctx, ctx_out):
    q, k, v, (i_f, f_f), (i_b, f_b) = lat
    qc, kc, vc, (ic_f, fc_f), (ic_b, fc_b) = ctx
    rev = lambda a: jnp.flip(a, axis=2)
    if ctx_out:
        b_, h_, _, dh = kc.shape
        zero = (jnp.zeros((b_, h_, dh, dh), jnp.float32), jnp.zeros((b_, h_, dh), jnp.float32),
                jnp.zeros((b_, h_), jnp.float32))
        hc_f, st_f = mlstm_chunk_scan(qc, kc, vc, ic_f, fc_f, zero)
        hc_b, st_b = mlstm_chunk_scan(rev(qc), rev(kc), rev(vc), rev(ic_b), rev(fc_b), zero)
        h_ctx = hc_f + rev(hc_b)
    else:
        st_f = mlstm_final_state(kc, vc, ic_f, fc_f)
        st_b = mlstm_final_state(rev(kc), rev(vc), rev(ic_b), rev(fc_b))
        h_ctx = None
    h_f, _ = mlstm_chunk_scan(q, k, v, i_f, f_f, st_f)
    h_b, _ = mlstm_chunk_scan(rev(q), rev(k), rev(v), rev(i_b), rev(f_b), st_b)
    return h_f + rev(h_b), h_ctx


def hybrid_layer(x, xc, mod, mod_c, norm1_g, w_in, a_ln_g, a_ln_b, a_ws, a_bs, b_rpb,
                 c_conv_w, c_conv_b, c_gate_b, w_out, norm2_g, w_gate, w_up, w_down, ctx_out):
    sh1, sc1, g1, sh2, sc2, g2 = [mod[:, i] for i in range(N_MOD)]
    csh1, csc1, cg1, csh2, csc2, cg2 = [mod_c[i] for i in range(N_MOD)]
    z = modulate(x, norm1_g, sh1, sc1) @ w_in
    zc = modulate(xc, norm1_g, csh1, csc1) @ w_in
    au, av, bq, bk, bv, cq, ck, cv, co, cg = split_cols(z)
    au_c, av_c, bq_c, bk_c, bv_c, cq_c, ck_c, cv_c, co_c, cg_c = split_cols(zc)

    y_a = chunk_token_mlp(au, av, a_ln_g, a_ln_b, a_ws, a_bs)
    k_ctx, v_ctx = to_heads(bk_c, B_HEADS), to_heads(bv_c, B_HEADS)
    y_b = from_heads(neighbourhood_attention(to_heads(bq, B_HEADS), to_heads(bk, B_HEADS),
                                             to_heads(bv, B_HEADS), k_ctx, v_ctx, b_rpb))
    lat_in = mlstm_inputs(cq, ck, cv, cg, c_conv_w, c_conv_b, c_gate_b, True)
    ctx_in = mlstm_inputs(cq_c, ck_c, cv_c, cg_c, c_conv_w, c_conv_b, c_gate_b, False)
    h_lat, h_ctx = mlstm_bidirectional(lat_in, ctx_in, ctx_out)
    y_c = from_heads(h_lat).astype(x.dtype) * jax.nn.sigmoid(co)

    x = x + g1 * (jnp.concatenate([y_a, y_b, y_c], axis=-1) @ w_out)
    x = x + g2 * swiglu(modulate(x, norm2_g, sh2, sc2), w_gate, w_up, w_down)

    if ctx_out:
        y_ac = chunk_token_mlp(au_c, av_c, a_ln_g, a_ln_b, a_ws, a_bs)
        y_bc = from_heads(context_attention(to_heads(bq_c, B_HEADS), k_ctx, v_ctx))
        y_cc = from_heads(h_ctx).astype(xc.dtype) * jax.nn.sigmoid(co_c)
        xc = xc + cg1 * (jnp.concatenate([y_ac, y_bc, y_cc], axis=-1) @ w_out)
        xc = xc + cg2 * swiglu(modulate(xc, norm2_g, csh2, csc2), w_gate, w_up, w_down)
    return x, xc


def setup_inputs(seed: int = 0) -> dict:
    key = jax.random.key(seed)
    ks = jax.random.split(key, 24)
    f32 = jnp.float32
    nrm = lambda k, shape, s: jax.random.normal(k, shape, f32) * s
    gate_i = nrm(ks[14], (DEPTH, 2, C_HEADS), 0.1)
    gate_f = jnp.linspace(3.0, 6.0, C_HEADS, dtype=f32) + nrm(ks[15], (DEPTH, 2, C_HEADS), 0.1)
    c_gate_b = jnp.stack([gate_i[:, 0], gate_f[:, 0], gate_i[:, 1], gate_f[:, 1]], axis=1)
    return {
        'x': nrm(ks[0], (BATCH, SEQ, D_MODEL), 1.0),
        'c': nrm(ks[1], (BATCH, D_MODEL), 1.0),
        'ctx': nrm(ks[2], (BATCH, CTX_LEN, D_MODEL), 1.0),
        'c_ctx': nrm(ks[3], (D_MODEL,), 1.0),
        'w_mod': nrm(ks[4], (DEPTH, D_MODEL, N_MOD * D_MODEL), 0.5 * D_MODEL ** -0.5),
        'b_mod': nrm(ks[5], (DEPTH, N_MOD * D_MODEL), 0.02),
        'norm1_g': 1.0 + nrm(ks[6], (DEPTH, D_MODEL), 0.02),
        'w_in': nrm(ks[7], (DEPTH, D_MODEL, IN_COLS), D_MODEL ** -0.5),
        'a_ln_g': 1.0 + nrm(ks[8], (DEPTH, A_GROUPS, HEAD_DIM), 0.02),
        'a_ln_b': nrm(ks[9], (DEPTH, A_GROUPS, HEAD_DIM), 0.02),
        'a_ws': nrm(ks[10], (DEPTH, A_GROUPS, A_CHUNK, A_CHUNK), A_CHUNK ** -0.5),
        'a_bs': 1.0 + nrm(ks[11], (DEPTH, A_GROUPS, A_CHUNK), 0.02),
        'b_rpb': nrm(ks[12], (DEPTH, B_HEADS, 2 * WIN_ROWS - 1, 2 * WIN_COLS - 1), 0.02),
        'c_conv_w': nrm(ks[13], (DEPTH, C_CONV, 2 * C_WIDTH), C_CONV ** -0.5),
        'c_conv_b': nrm(ks[16], (DEPTH, 2 * C_WIDTH), 0.02),
        'c_gate_b': c_gate_b,
        'w_out': nrm(ks[17], (DEPTH, MIX_WIDTH, D_MODEL), MIX_WIDTH ** -0.5),
        'norm2_g': 1.0 + nrm(ks[18], (DEPTH, D_MODEL), 0.02),
        'w_gate': nrm(ks[19], (DEPTH, D_MODEL, D_FF), D_MODEL ** -0.5),
        'w_up': nrm(ks[20], (DEPTH, D_MODEL, D_FF), D_MODEL ** -0.5),
        'w_down': nrm(ks[21], (DEPTH, D_FF, D_MODEL), D_FF ** -0.5),
        'final_g': 1.0 + nrm(ks[22], (D_MODEL,), 0.02),
    }


def reference(x, c, ctx, c_ctx, w_mod, b_mod, norm1_g, w_in, a_ln_g, a_ln_b, a_ws, a_bs, b_rpb,
              c_conv_w, c_conv_b, c_gate_b, w_out, norm2_g, w_gate, w_up, w_down, final_g):
    b_, _, d = x.shape
    xc = ctx
    for l in range(DEPTH):
        mod = (jax.nn.silu(c) @ w_mod[l] + b_mod[l]).reshape(b_, N_MOD, 1, d)
        mod_c = (jax.nn.silu(c_ctx) @ w_mod[l] + b_mod[l]).reshape(N_MOD, d)
        x, xc = hybrid_layer(x, xc, mod, mod_c, norm1_g[l], w_in[l], a_ln_g[l], a_ln_b[l], a_ws[l], a_bs[l],
                             b_rpb[l], c_conv_w[l], c_conv_b[l], c_gate_b[l], w_out[l], norm2_g[l],
                             w_gate[l], w_up[l], w_down[l], l < DEPTH - 1)
    return rms_norm(x, final_g)
```

```cpp
#include <hip/hip_runtime.h>
#include <cstdio>
#include <cstdint>

namespace pg8 {
#define PG8_LAS __attribute__((address_space(3)))
typedef unsigned short bf16_t;
typedef short bf16x8 __attribute__((ext_vector_type(8)));
typedef float f32x4 __attribute__((ext_vector_type(4)));
typedef unsigned u32x4 __attribute__((ext_vector_type(4)));
constexpr int BM = 256, BK = 64, HALF = 128, HTB = HALF * BK * 2  , STAGE_BYTES = 8 * HTB, NXCD = 8, WGM = 8;

__host__ __device__ __forceinline__ int lds_byte(int r, int c) { const int st = (r >> 4) * 2 + (c >> 5), rr = r & 15, cc = c & 31, ob = rr * 64 + cc * 2; return st * 1024 + (ob ^ (((ob >> 9) & 1) << 5)); }
__host__ __device__ __forceinline__ void stage_rc(int b, int& R, int& C) { const int st = b / 1024, sb = b % 1024, swz = sb ^ (((sb >> 9) & 1) << 5); R = (st >> 1) * 16 + swz / 64; C = (st & 1) * 32 + (swz % 64) / 2; }
__host__ __device__ __forceinline__ int perm32(int rho) { const int n = rho >> 4, i = rho & 15; return 8 * (i >> 2) + 4 * n + (i & 3); }

struct Unit { int pm, pn; };
struct Gemm { const bf16_t* A; const bf16_t* Bt; int M, N, K; };

struct StaticOrder {
    int nM, nN, nwg, G, c;
    __host__ __device__ void init(int M, int N, int G_, int c_) { nM = M / BM; nN = N / BM; nwg = nM * nN; G = G_; c = c_; }
    __host__ __device__ bool next(int i, Unit& u) const {
        const long L = (long)i * G + c; if (L >= nwg) return false;
        int wgid = (int)L; { const int q = nwg / NXCD, r = nwg % NXCD, xcd = wgid % NXCD, off = wgid / NXCD; wgid = (xcd < r ? xcd * (q + 1) : r * (q + 1) + (xcd - r) * q) + off; }
        const int nig = WGM * nN, gid = wgid / nig, fm = gid * WGM, gsz = (nM - fm) < WGM ? (nM - fm) : WGM;
        u.pm = fm + ((wgid % nig) % gsz); u.pn = (wgid % nig) / gsz; return true;
    }
    __device__ __forceinline__ void a_ready(const Unit&) const {}
    __device__ __forceinline__ void done(const Unit&) const {}
};


__device__ __forceinline__ unsigned cvt_pk_bf16(float lo, float hi) { unsigned r; asm volatile("v_cvt_pk_bf16_f32 %0, %1, %2" : "=v"(r) : "v"(lo), "v"(hi)); return r; }
typedef float f32x2 __attribute__((ext_vector_type(2)));
__device__ __forceinline__ f32x2 gelu_pk(f32x2 v) {
    const f32x2 av = __builtin_elementwise_abs(v), d = av * 0.2316418882f + 1.0f;
    f32x2 t; t.x = __builtin_amdgcn_rcpf(d.x); t.y = __builtin_amdgcn_rcpf(d.y);
    f32x2 q = t * 0.5307027145f + (-0.7265760135f); q = q * t + 0.7107068705f; q = q * t + (-0.142248368f); q = q * t + 0.127414796f; q = q * t;
    const f32x2 s = (v * v) * (-0.72134752044f);
    f32x2 e; e.x = __builtin_amdgcn_exp2f(s.x); e.y = __builtin_amdgcn_exp2f(s.y);
    const f32x2 m = v * (q * e), r = v - m;
    f32x2 o; o.x = v.x < 0.f ? m.x : r.x; o.y = v.y < 0.f ? m.y : r.y; return o;
}

template <int ACT  > struct EpiBf16 {
    static constexpr bool PERM = true, AFTER_DRAIN = false; static_assert(ACT == 0 || ACT == 1, "EpiBf16: ACT is 0 (none) or 1 (gelu_pk)");
    bf16_t* O; int ldc; const float* bias; int split_cols; size_t split_stride; float scale0;
    __device__ __forceinline__ void operator()(const f32x4 (&acc)[2][2][4][2], const Unit& u, int wr, int wc, int fr, int fq) const {
        const int row0 = u.pm * BM + wr * 64 + fr; int colt = u.pn * BM; bf16_t* base = O;
        float sc = 1.f; if (split_cols) { const int t = colt / split_cols; base += (size_t)t * split_stride; colt -= t * split_cols; if (t == 0) sc = scale0; }
        const int col0 = colt + wc * 32 + 8 * fq, bcol0 = u.pn * BM + wc * 32 + 8 * fq;
        f32x4 bv[2][2];
#pragma unroll
        for (int bj = 0; bj < 2; ++bj)
#pragma unroll
            for (int n = 0; n < 2; ++n) bv[bj][n] = bias ? *(const f32x4*)(bias + bcol0 + bj * HALF + 4 * n) : (f32x4){0.f, 0.f, 0.f, 0.f};
#pragma unroll
        for (int ai = 0; ai < 2; ++ai)
#pragma unroll
            for (int m = 0; m < 4; ++m) { bf16_t* rowp = base + (size_t)(row0 + ai * HALF + m * 16) * ldc + col0;
#pragma unroll
                for (int bj = 0; bj < 2; ++bj) { f32x4 v0 = acc[ai][bj][m][0] + bv[bj][0], v1 = acc[ai][bj][m][1] + bv[bj][1];
                    if (ACT == 1) { f32x2 a = gelu_pk((f32x2){v0[0], v0[1]}), b = gelu_pk((f32x2){v0[2], v0[3]}), c = gelu_pk((f32x2){v1[0], v1[1]}), d = gelu_pk((f32x2){v1[2], v1[3]});
                        v0 = (f32x4){a.x, a.y, b.x, b.y}; v1 = (f32x4){c.x, c.y, d.x, d.y}; }
                    v0 = v0 * sc; v1 = v1 * sc; u32x4 w; w.x = cvt_pk_bf16(v0[0], v0[1]); w.y = cvt_pk_bf16(v0[2], v0[3]); w.z = cvt_pk_bf16(v1[0], v1[1]); w.w = cvt_pk_bf16(v1[2], v1[3]);
                    *(u32x4*)(rowp + bj * HALF) = w; } }
    }
};


template <class Epi, class Sched, bool ALIGN_EPI = false, bool SP2 = false>
__device__ __forceinline__ void gemm_phase(PG8_LAS unsigned char* lds, const Gemm g, const Sched& S, const Epi& E) {
    int tid_l = threadIdx.x; asm volatile("" : "+v"(tid_l));
    const int tid = tid_l, wid = __builtin_amdgcn_readfirstlane(tid >> 6), lane = tid & 63, wr = wid >> 2, wc = wid & 3, fr = lane & 15, fq = lane >> 4;
    const int K = g.K, nt = K / BK;
    unsigned voffA[2], voffB[2];
#pragma unroll
    for (int i = 0; i < 2; ++i) { int R, C; stage_rc(tid * 16 + i * 8192, R, C); const int Rb = Epi::PERM ? ((R & ~31) + perm32(R & 31)) : R;
        voffA[i] = (unsigned)(R * K + C) * 2u; voffB[i] = (unsigned)(Rb * K + C) * 2u; }
    const size_t kstep = (size_t)(BK * 2);
    const size_t hstep = (size_t)HALF * K * 2;
    const size_t tstep = 2 * hstep;
    const unsigned ldsw = (unsigned)wid * 1024u;
    const int aoff = lds_byte(wr * 64 + fr, fq * 8), boff = lds_byte(wc * 32 + fr, fq * 8);
#define PG8_SA(b, h) (((b) * 2 + (h)) * HTB)
#define PG8_SB(b, h) ((4 + (b) * 2 + (h)) * HTB)
#define PG8_STAGE(bufoff, gbase, voff) do { _Pragma("unroll") for (int _i = 0; _i < 2; ++_i) \
        __builtin_amdgcn_global_load_lds((const unsigned*)((const char*)(gbase) + (voff)[_i]), (PG8_LAS unsigned*)(lds + (bufoff) + ldsw + _i * 8192), 16, 0, 0); } while (0)
#define PG8_LDA(dst, b, h) do { _Pragma("unroll") for (int m = 0; m < 4; ++m) _Pragma("unroll") for (int k = 0; k < 2; ++k) dst[m][k] = *(const PG8_LAS bf16x8*)(lds + PG8_SA(b, h) + aoff + m * 2048 + k * 1024); } while (0)
#define PG8_LDB(dst, b, h) do { _Pragma("unroll") for (int n = 0; n < 2; ++n) _Pragma("unroll") for (int k = 0; k < 2; ++k) dst[n][k] = *(const PG8_LAS bf16x8*)(lds + PG8_SB(b, h) + boff + n * 2048 + k * 1024); } while (0)
#define PG8_MMA(ai, bj, At, Bt) do { __builtin_amdgcn_s_setprio(1); _Pragma("unroll") for (int m = 0; m < 4; ++m) _Pragma("unroll") for (int n = 0; n < 2; ++n) _Pragma("unroll") for (int k = 0; k < 2; ++k) \
        acc[ai][bj][m][n] = __builtin_amdgcn_mfma_f32_16x16x32_bf16(Bt[n][k], At[m][k], acc[ai][bj][m][n], 0, 0, 0); __builtin_amdgcn_s_setprio(0); } while (0)
#define PG8_WAIT_V(n) asm volatile("s_waitcnt vmcnt(" #n ")" ::: "memory")
#define PG8_WAIT_L(n) asm volatile("s_waitcnt lgkmcnt(" #n ")" ::: "memory")
#define PG8_BAR __builtin_amdgcn_s_barrier()
#define PG8_SCHED __builtin_amdgcn_sched_barrier(0)
    Unit cur, nxt; int ui = 0;
    if (!S.next(0, cur)) return;
    f32x4 acc[2][2][4][2];
#pragma unroll
    for (int a = 0; a < 2; ++a)
#pragma unroll
        for (int b = 0; b < 2; ++b)
#pragma unroll
            for (int m = 0; m < 4; ++m)
#pragma unroll
                for (int n = 0; n < 2; ++n) acc[a][b][m][n] = (f32x4){0.f, 0.f, 0.f, 0.f};
    bf16x8 At[4][2], B0[2][2], B1[2][2];
    const char* cA = (const char*)g.A + (size_t)cur.pm * tstep; const char* cB = (const char*)g.Bt + (size_t)cur.pn * tstep;
    S.a_ready(cur);
    if constexpr (SP2) {
        PG8_STAGE(PG8_SB(0, 0), cB, voffB); PG8_STAGE(PG8_SB(0, 1), cB + hstep, voffB); PG8_STAGE(PG8_SA(0, 0), cA, voffA); PG8_STAGE(PG8_SA(0, 1), cA + hstep, voffA);
        if (wr == 1) PG8_BAR;
        PG8_WAIT_V(2); PG8_BAR;
        PG8_STAGE(PG8_SB(1, 0), cB + kstep, voffB); PG8_STAGE(PG8_SA(1, 0), cA + kstep, voffA); PG8_STAGE(PG8_SB(1, 1), cB + hstep + kstep, voffB);
        PG8_WAIT_V(6); PG8_BAR;
    } else {
        PG8_STAGE(PG8_SB(0, 0), cB, voffB); PG8_STAGE(PG8_SA(0, 0), cA, voffA); PG8_STAGE(PG8_SB(0, 1), cB + hstep, voffB); PG8_STAGE(PG8_SA(0, 1), cA + hstep, voffA);
        if (wr == 1) PG8_BAR;
        PG8_WAIT_V(4); PG8_BAR;
        PG8_STAGE(PG8_SB(1, 0), cB + kstep, voffB); PG8_STAGE(PG8_SA(1, 0), cA + kstep, voffA); PG8_STAGE(PG8_SB(1, 1), cB + hstep + kstep, voffB);
        PG8_WAIT_V(6); PG8_BAR;
    }
    for (;;) {
        const bool has_next = S.next(ui + 1, nxt);
        const char* nA = has_next ? (const char*)g.A + (size_t)nxt.pm * tstep : cA; const char* nB = has_next ? (const char*)g.Bt + (size_t)nxt.pn * tstep : cB;
        for (int t = 0; t < nt; t += 2) {
            const bool last = (t == nt - 2);
            const char* a1 = cA + (size_t)(t + 1) * kstep;
            const char* a2 = last ? nA : cA + (size_t)(t + 2) * kstep; const char* b2 = last ? nB : cB + (size_t)(t + 2) * kstep;
            const char* a3 = a2 + kstep; const char* b3 = b2 + kstep;
            if (last && has_next) S.a_ready(nxt);
            if constexpr (SP2) {
            PG8_LDB(B0, 0, 0); PG8_LDB(B1, 0, 1); PG8_SCHED; PG8_LDA(At, 0, 0); PG8_STAGE(PG8_SA(1, 1), a1 + hstep, voffA);
            PG8_WAIT_V(8); PG8_WAIT_L(0); PG8_BAR; PG8_MMA(0, 0, At, B0); PG8_MMA(0, 1, At, B1); PG8_BAR; PG8_SCHED;
            PG8_LDA(At, 0, 1); PG8_STAGE(PG8_SB(0, 0), b2, voffB); PG8_STAGE(PG8_SB(0, 1), b2 + hstep, voffB); PG8_STAGE(PG8_SA(0, 0), a2, voffA);
            PG8_WAIT_V(8); PG8_WAIT_L(0); PG8_BAR; PG8_MMA(1, 0, At, B0); PG8_MMA(1, 1, At, B1); PG8_BAR; PG8_SCHED;
            PG8_LDB(B0, 1, 0); PG8_LDB(B1, 1, 1); PG8_SCHED; PG8_LDA(At, 1, 0); PG8_STAGE(PG8_SA(0, 1), a2 + hstep, voffA);
            PG8_WAIT_V(8); PG8_WAIT_L(0); PG8_BAR; PG8_MMA(0, 0, At, B0); PG8_MMA(0, 1, At, B1); PG8_BAR; PG8_SCHED;
            PG8_LDA(At, 1, 1); PG8_STAGE(PG8_SB(1, 0), b3, voffB); PG8_STAGE(PG8_SB(1, 1), b3 + hstep, voffB); PG8_STAGE(PG8_SA(1, 0), a3, voffA);
            PG8_WAIT_V(8); PG8_WAIT_L(0); PG8_BAR; PG8_MMA(1, 0, At, B0); PG8_MMA(1, 1, At, B1); PG8_BAR; PG8_SCHED;
            } else {
            PG8_LDB(B0, 0, 0); PG8_SCHED; PG8_LDA(At, 0, 0); PG8_STAGE(PG8_SA(1, 1), a1 + hstep, voffA);
            PG8_WAIT_L(8); PG8_BAR; PG8_WAIT_L(0); PG8_MMA(0, 0, At, B0); PG8_BAR; PG8_SCHED;
            PG8_LDB(B1, 0, 1); PG8_STAGE(PG8_SB(0, 0), b2, voffB);
            PG8_BAR; PG8_WAIT_L(0); PG8_MMA(0, 1, At, B1); PG8_BAR;
            PG8_LDA(At, 0, 1); PG8_STAGE(PG8_SA(0, 0), a2, voffA);
            PG8_BAR; PG8_WAIT_L(0); PG8_MMA(1, 0, At, B0); PG8_BAR; PG8_SCHED;
            PG8_STAGE(PG8_SB(0, 1), b2 + hstep, voffB);
            PG8_WAIT_V(6); PG8_BAR; PG8_MMA(1, 1, At, B1); PG8_BAR;
            PG8_LDB(B0, 1, 0); PG8_SCHED; PG8_LDA(At, 1, 0); PG8_STAGE(PG8_SA(0, 1), a2 + hstep, voffA);
            PG8_WAIT_L(8); PG8_BAR; PG8_WAIT_L(0); PG8_MMA(0, 0, At, B0); PG8_BAR; PG8_SCHED;
            PG8_LDB(B1, 1, 1); PG8_STAGE(PG8_SB(1, 0), b3, voffB);
            PG8_BAR; PG8_WAIT_L(0); PG8_MMA(0, 1, At, B1); PG8_BAR;
            PG8_LDA(At, 1, 1); PG8_STAGE(PG8_SA(1, 0), a3, voffA);
            PG8_BAR; PG8_WAIT_L(0); PG8_MMA(1, 0, At, B0); PG8_BAR; PG8_SCHED;
            PG8_STAGE(PG8_SB(1, 1), b3 + hstep, voffB);
            PG8_WAIT_V(6); PG8_BAR; PG8_MMA(1, 1, At, B1); PG8_BAR;
            }
        }
        if constexpr (ALIGN_EPI) { if (wr == 0) PG8_BAR; }
        if constexpr (!Epi::AFTER_DRAIN) { E(acc, cur, wr, wc, fr, fq); S.done(cur); }
        if (!has_next) break;
#pragma unroll
        for (int a = 0; a < 2; ++a)
#pragma unroll
            for (int b = 0; b < 2; ++b)
#pragma unroll
                for (int m = 0; m < 4; ++m)
#pragma unroll
                    for (int n = 0; n < 2; ++n) acc[a][b][m][n] = (f32x4){0.f, 0.f, 0.f, 0.f};
        cur = nxt; cA = nA; cB = nB; ++ui;
        if constexpr (ALIGN_EPI) { if (wr == 1) PG8_BAR; }
    }
    PG8_WAIT_V(0);
    if constexpr (!ALIGN_EPI) { if (wr == 0) PG8_BAR; }
    PG8_BAR;
    if constexpr (Epi::AFTER_DRAIN) { E.fused(acc, cur, wr, wc, fr, fq, lds, wid, lane); S.done(cur); }
#undef PG8_SA
#undef PG8_SB
#undef PG8_STAGE
#undef PG8_LDA
#undef PG8_LDB
#undef PG8_MMA
#undef PG8_WAIT_V
#undef PG8_WAIT_L
#undef PG8_BAR
#undef PG8_SCHED
}
}
#define GAS __attribute__((address_space(1)))
#define LAS __attribute__((address_space(3)))
typedef unsigned short bf16;
typedef unsigned v4u __attribute__((ext_vector_type(4)));
typedef float f32x4 __attribute__((ext_vector_type(4)));
typedef short bf16x8 __attribute__((ext_vector_type(8)));
typedef GAS unsigned gu32;
typedef GAS unsigned long long gu64;
#define RLX_AGENT __ATOMIC_RELAXED, __HIP_MEMORY_SCOPE_AGENT
#define LDS_WAIT() asm volatile("s_waitcnt lgkmcnt(0)" ::: "memory")
#define VM_WAIT() asm volatile("s_waitcnt vmcnt(0)" ::: "memory")
__device__ __forceinline__ unsigned long long rt() { return __builtin_amdgcn_s_memrealtime(); }
__device__ __forceinline__ unsigned f2bf(float f) { unsigned u = __builtin_bit_cast(unsigned, f); return (u + 0x7fffu + ((u >> 16) & 1u)) >> 16; }
__device__ __forceinline__ unsigned pk2(float lo, float hi) { return f2bf(lo) | (f2bf(hi) << 16); }

#define XB_TMO      128
#define XB_XCNT(j)  (256  + 64 * (j))
#define XB_XSUB(j)  (1280 + 64 * (j))
#define XB_XGEN(j)  (2304 + 64 * (j))
#define XB_TOP      3328
#define XB_TOPGEN   3392
#define XCD_BAR_WORDS 3456
#define XB_SPIN_CAP (1u << 18)

__device__ __forceinline__ unsigned xb_ld(unsigned* p)              { return __hip_atomic_load(p, __ATOMIC_RELAXED, __HIP_MEMORY_SCOPE_AGENT); }
__device__ __forceinline__ unsigned xb_add(unsigned* p, unsigned v) { return __hip_atomic_fetch_add(p, v, __ATOMIC_RELAXED, __HIP_MEMORY_SCOPE_AGENT); }
__device__ __forceinline__ unsigned xb_xcc_id() { return (unsigned)__builtin_amdgcn_s_getreg((3 << 11) | 20) & 0xFu; }
#define XB_SPIN(cond, bar) do { unsigned _sp = 0; while (cond) { __builtin_amdgcn_s_sleep(1); \
    if ((++_sp & 255u) == 0u) { if (xb_ld(&(bar)[XB_TMO])) break; if (_sp > XB_SPIN_CAP) { atomicAdd(&(bar)[XB_TMO], 1u); break; } } } } while (0)

struct XcdBarrier {
    unsigned* bar; unsigned x;
    volatile LAS unsigned* st;
};

__device__ __forceinline__ XcdBarrier xcd_barrier_post(unsigned* bar, volatile LAS unsigned* st) {
    XcdBarrier b; b.bar = bar; b.x = xb_xcc_id(); b.st = st;
    if (threadIdx.x == 0) (void)xb_add(&bar[XB_XCNT(b.x)], 1u);
    return b;
}
__device__ __forceinline__ void xcd_barrier_complete(unsigned* bar, unsigned x, unsigned& nloc, unsigned& nx) {
    const unsigned G = gridDim.x * gridDim.y * gridDim.z;
    unsigned sum, cnt, mine, sp = 0u;
    for (;;) {
        sum = 0u; cnt = 0u; mine = 0u;
#pragma unroll
        for (unsigned j = 0; j < 16; ++j) { const unsigned c = xb_ld(&bar[XB_XCNT(j)]); sum += c; cnt += (c > 0u) ? 1u : 0u; mine = (j == x) ? c : mine; }
        if (sum == G) break;
        __builtin_amdgcn_s_sleep(1);
        if ((++sp & 255u) == 0u) { if (xb_ld(&bar[XB_TMO])) break; if (sp > XB_SPIN_CAP) { atomicAdd(&bar[XB_TMO], 1u); break; } }
    }
    nloc = mine > 0u ? mine : 1u; nx = cnt > 0u ? cnt : 1u;
}

__device__ __forceinline__ void xcd_barrier(const XcdBarrier& b) {
    asm volatile("s_waitcnt vmcnt(0)" ::: "memory");
    __syncthreads();
    if (threadIdx.x == 0) {
        unsigned* bar = b.bar;
        __builtin_amdgcn_s_waitcnt(0);
        unsigned nloc = b.st[0], nx = b.st[1];
        if (nloc == 0u) { xcd_barrier_complete(bar, b.x, nloc, nx); b.st[0] = nloc; b.st[1] = nx; }
        const unsigned old = xb_add(&bar[XB_XSUB(b.x)], 1u);
        const unsigned gen = old / nloc;
        if (old + 1u == (gen + 1u) * nloc) {
            __builtin_amdgcn_fence(__ATOMIC_RELEASE, "agent");
            asm volatile("s_waitcnt vmcnt(0)" ::: "memory");
            const unsigned og = xb_add(&bar[XB_TOP], 1u);
            const unsigned tg = og / nx;
            if (og + 1u == (tg + 1u) * nx) xb_add(&bar[XB_TOPGEN], 1u);
            else XB_SPIN(xb_ld(&bar[XB_TOPGEN]) == tg, bar);
            __builtin_amdgcn_fence(__ATOMIC_ACQUIRE, "agent");
            xb_add(&bar[XB_XGEN(b.x)], 1u);
            asm volatile("s_waitcnt vmcnt(0)" ::: "memory");
        } else {
            XB_SPIN(xb_ld(&bar[XB_XGEN(b.x)]) == gen, bar);
            __builtin_amdgcn_fence(__ATOMIC_ACQUIRE, "agent");
            asm volatile("s_waitcnt vmcnt(0)" ::: "memory");
        }
    }
    __syncthreads();
}

constexpr int DM = 1024, NB = 16, SEQ = 4096, CTXL = 256;
constexpr int NLAT = NB * SEQ;
constexpr int NCTX = NB * CTXL;
constexpr int MROWS = NLAT + NCTX;
constexpr int INC = 3224, ZW = 3328, DFF = 2816;
constexpr int Z_AU = 0, Z_AV = 256, Z_BQ = 512, Z_BK = 896, Z_BV = 1280, Z_CQ = 1664, Z_CK = 2048, Z_CV = 2432, Z_CO = 2816, Z_CG = 3200;
constexpr int Y_A = 0, Y_B = 256, Y_C = 640;
constexpr float EPS = 1e-6f;
constexpr int NWAVES = 8, NTHR = 512;

constexpr size_t MiB = 1u << 20;
constexpr size_t WS_CTL = 0, CTL_ZERO_BYTES = 1 * MiB;
constexpr size_t WS_MOD = 1 * MiB;
constexpr size_t WIN_BYTES = (size_t)ZW * DM * 2, WOUT_BYTES = (size_t)DM * DM * 2, WGU_BYTES = (size_t)2 * DFF * DM * 2, WDN_BYTES = (size_t)DM * DFF * 2;
constexpr size_t WS_WIN = 2 * MiB;
constexpr size_t WS_WOUT = WS_WIN + 2 * WIN_BYTES;
constexpr size_t WS_WGU = WS_WOUT + 2 * WOUT_BYTES;
constexpr size_t WS_WDN = WS_WGU + 2 * WGU_BYTES;
constexpr size_t WS_XRC = WS_WDN + 2 * WDN_BYTES;
constexpr size_t WS_XN = WS_XRC + (size_t)NCTX * DM * 4;
constexpr size_t WS_Z = WS_XN + (size_t)MROWS * DM * 2;
constexpr size_t WS_HF = WS_Z + (size_t)MROWS * ZW * 2;
constexpr size_t WS_END = WS_HF + (size_t)MROWS * 384 * 4;
static_assert(WS_XRC == 52 * MiB && WS_XN == 68 * MiB && WS_Z == 204 * MiB && WS_HF == 646 * MiB && WS_END == 748 * MiB, "d_ws map");
constexpr int CW_BAR = 4096;

constexpr int RING_BYTES = 131072;
constexpr int LDSCTL_OFF = RING_BYTES, MISC_OFF = LDSCTL_OFF + 320;
constexpr int LDS_BYTES = 147456;


__device__ __forceinline__ float bflo(unsigned u) { return __uint_as_float(u << 16); }
__device__ __forceinline__ float bfhi(unsigned u) { return __uint_as_float(u & 0xffff0000u); }
__device__ __forceinline__ float bf2f(bf16 v) { return __uint_as_float(((unsigned)v) << 16); }
__device__ __forceinline__ float sigmoidf_(float x) { return 1.f / (1.f + __expf(-x)); }
__device__ __forceinline__ float siluf_(float x) { return x / (1.f + __expf(-x)); }
__device__ __forceinline__ float gelu_tanh(float x) { const float u = 0.7978845608028654f * (x + 0.044715f * x * x * x); return x / (1.f + __expf(-2.f * u)); }
__device__ __forceinline__ float wave_sum(float v) {
#pragma unroll
    for (int o = 1; o < 64; o <<= 1) v += __shfl_xor(v, o);
    return v;
}

namespace pg8 {
struct EpiRes {
    static constexpr bool PERM = false, AFTER_DRAIN = false;
    const float* res_lat; const float* res_ctx; float* out_lat; float* out_ctx; const float* modl; int gidx;
    __device__ __forceinline__ void operator()(const f32x4 (&acc)[2][2][4][2], const Unit& u, int wr, int wc, int fr, int fq) const {
        const bool lat = u.pm < 256;
        const size_t pbase = (size_t)(lat ? u.pm : u.pm - 256) * 256 * DM;
        const float* rs = (lat ? res_lat : res_ctx) + pbase; float* os = (lat ? out_lat : out_ctx) + pbase;
        const float* gate = modl + (size_t)(lat ? (u.pm >> 4) : 16) * 6144 + gidx * 1024;
        const int rl = wr * 64 + fr, col0 = u.pn * BM + wc * 32 + 4 * fq;
        gate += col0;
#pragma unroll
        for (int ai = 0; ai < 2; ++ai)
#pragma unroll
            for (int m = 0; m < 4; ++m) { const unsigned ro = (unsigned)(rl + ai * HALF + m * 16) * DM + col0;
#pragma unroll
                for (int bj = 0; bj < 2; ++bj)
#pragma unroll
                    for (int n = 0; n < 2; ++n) { const f32x4 r = *(const f32x4*)(rs + ro + bj * HALF + n * 16); const f32x4 gq = *(const f32x4*)(gate + bj * HALF + n * 16); *(f32x4*)(os + ro + bj * HALF + n * 16) = r + gq * acc[ai][bj][m][n]; }
                asm volatile("" ::: "memory"); }
    }
};
struct EpiSwiGLU {
    static constexpr bool PERM = true, AFTER_DRAIN = false;
    bf16_t* H;
    __device__ __forceinline__ void operator()(const f32x4 (&acc)[2][2][4][2], const Unit& u, int wr, int wc, int fr, int fq) const {
        const int row0 = u.pm * BM + wr * 64 + fr, col0 = u.pn * HALF + wc * 32 + 8 * fq;
#pragma unroll
        for (int ai = 0; ai < 2; ++ai)
#pragma unroll
            for (int m = 0; m < 4; ++m) { bf16_t* rowp = H + (size_t)(row0 + ai * HALF + m * 16) * DFF + col0;
                float h[8];
#pragma unroll
                for (int n = 0; n < 2; ++n)
#pragma unroll
                    for (int j = 0; j < 4; ++j) { const float g = acc[ai][0][m][n][j], up = acc[ai][1][m][n][j]; h[n * 4 + j] = g / (1.f + __expf(-g)) * up; }
                u32x4 w; w.x = cvt_pk_bf16(h[0], h[1]); w.y = cvt_pk_bf16(h[2], h[3]); w.z = cvt_pk_bf16(h[4], h[5]); w.w = cvt_pk_bf16(h[6], h[7]);
                *(u32x4*)rowp = w; }
    }
};
}

struct Args { const float* in[22]; float* out; unsigned char* ws; int ph_lo, ph_hi; };
static_assert(sizeof(Args) == 22 * 8 + 8 + 8 + 8, "Args has no padding");
enum { I_X = 0, I_C, I_CTX, I_CCTX, I_WMOD, I_BMOD, I_N1G, I_WIN, I_ALNG, I_ALNB, I_AWS, I_ABS, I_RPB, I_CONVW, I_CONVB, I_GATEB, I_WOUT, I_N2G, I_WGATE, I_WUP, I_WDOWN, I_FING };
constexpr int NPHASE = 20;
typedef const __attribute__((address_space(4))) unsigned char* kptr_t;
__device__ __forceinline__ kptr_t kargs() { kptr_t p = (kptr_t)__builtin_amdgcn_kernarg_segment_ptr(); asm volatile("" : "+s"(p)); return p; }
#define KIN(i) (*(const float* const __attribute__((address_space(4)))*)(kp + 8 * (i)))
#define KOUT() (*(float* const __attribute__((address_space(4)))*)(kp + 8 * 22))
#define KWS() (*(unsigned char* const __attribute__((address_space(4)))*)(kp + 8 * 23))

struct Frame {
    LAS unsigned char* lds;
    int tid, lane, wave, G, gw, NGW;
};

__device__ __forceinline__ void p0_transpose_item(const float* W, int K, int N, bf16* WT, int nblk, int item, LAS float* scr, int lane, int grp, int gstride, int goff) {
    const int kb = item / nblk, nb = item % nblk, k0 = 64 * kb, n0 = 32 * nb;
    const int nn = n0 + (lane & 31);
#pragma unroll 8
    for (int i = 0; i < 32; ++i) { const int kk = 2 * i + (lane >> 5); scr[kk * 33 + (lane & 31)] = (nn < N) ? W[(size_t)(k0 + kk) * N + nn] : 0.f; }
    LDS_WAIT(); asm volatile("" ::: "memory");
    const int c = lane & 7;
#pragma unroll
    for (int j = 0; j < 4; ++j) { const int n = (lane >> 3) + 8 * j; const LAS float* s = scr + (8 * c) * 33 + n;
        v4u o; o.x = pk2(s[0 * 33], s[1 * 33]); o.y = pk2(s[2 * 33], s[3 * 33]); o.z = pk2(s[4 * 33], s[5 * 33]); o.w = pk2(s[6 * 33], s[7 * 33]);
        const int sn = n0 + n; const int dr = grp ? (sn / grp) * gstride + goff + sn % grp : sn;
        *(GAS v4u*)(WT + (size_t)dr * K + k0 + 8 * c) = o; }
    LDS_WAIT(); asm volatile("" ::: "memory");
}

__device__ __forceinline__ void p0_prologue(Frame& F, kptr_t kp) {
    {
        LAS float* scr = (LAS float*)(F.lds + F.wave * 16384);
        constexpr int I_IN = 16 * (ZW / 32), I_OUT = 16 * 32, I_G = 16 * (DFF / 32), I_D = (DFF / 64) * 32, PER_L = I_IN + I_OUT + 2 * I_G + I_D;
        for (int it = F.gw; it < 2 * PER_L; it += F.NGW) {
            const int l = it / PER_L; int r = it % PER_L;
            if (r < I_IN) { p0_transpose_item(KIN(I_WIN) + (size_t)l * DM * INC, DM, INC, (bf16*)(KWS() + WS_WIN + l * WIN_BYTES), ZW / 32, r, scr, F.lane, 0, 0, 0); continue; } r -= I_IN;
            if (r < I_OUT) { p0_transpose_item(KIN(I_WOUT) + (size_t)l * DM * DM, DM, DM, (bf16*)(KWS() + WS_WOUT + l * WOUT_BYTES), 32, r, scr, F.lane, 0, 0, 0); continue; } r -= I_OUT;
            if (r < I_G) { p0_transpose_item(KIN(I_WGATE) + (size_t)l * DM * DFF, DM, DFF, (bf16*)(KWS() + WS_WGU + l * WGU_BYTES), DFF / 32, r, scr, F.lane, 128, 256, 0); continue; } r -= I_G;
            if (r < I_G) { p0_transpose_item(KIN(I_WUP) + (size_t)l * DM * DFF, DM, DFF, (bf16*)(KWS() + WS_WGU + l * WGU_BYTES), DFF / 32, r, scr, F.lane, 128, 256, 128); continue; } r -= I_G;
            p0_transpose_item(KIN(I_WDOWN) + (size_t)l * DFF * DM, DFF, DM, (bf16*)(KWS() + WS_WDN + l * WDN_BYTES), 32, r, scr, F.lane, 0, 0, 0);
        }
    }
    __syncthreads();
    if ((int)blockIdx.x < 96) {
        LAS float* sc = (LAS float*)F.lds;
        LAS float* part = (LAS float*)(F.lds + 17 * 1024 * 4);
        for (int i = F.tid; i < 17 * 1024; i += NTHR) { const int b = i >> 10, k = i & 1023; const float v = (b < 16) ? KIN(I_C)[b * 1024 + k] : KIN(I_CCTX)[k]; sc[i] = siluf_(v); }
        __syncthreads();
        float* MOD = (float*)(KWS() + WS_MOD);
        for (int unit = blockIdx.x; unit < 96; unit += F.G) {
            const int l = unit / 48, slab = unit % 48, cc = F.tid & 127, kq = F.tid >> 7;
            const float* wp = KIN(I_WMOD) + ((size_t)l * 1024 + kq * 256) * 6144 + slab * 128 + cc;
            float acc[17];
#pragma unroll
            for (int b = 0; b < 17; ++b) acc[b] = 0.f;
            for (int k = 0; k < 256; ++k) { const float w = wp[(size_t)k * 6144];
#pragma unroll
                for (int b = 0; b < 17; ++b) acc[b] += sc[b * 1024 + kq * 256 + k] * w; }
#pragma unroll
            for (int b = 0; b < 17; ++b) part[(kq * 17 + b) * 128 + cc] = acc[b];
            __syncthreads();
            for (int i = F.tid; i < 17 * 128; i += NTHR) { const int b = i >> 7, c2 = i & 127;
                const float s = part[(0 * 17 + b) * 128 + c2] + part[(1 * 17 + b) * 128 + c2] + part[(2 * 17 + b) * 128 + c2] + part[(3 * 17 + b) * 128 + c2];
                MOD[((size_t)l * 17 + b) * 6144 + slab * 128 + c2] = s + KIN(I_BMOD)[l * 6144 + slab * 128 + c2]; }
            __syncthreads();
        }
    }
}

__device__ __forceinline__ void norm_mod_phase(Frame& F, const float* src_lat, const float* src_ctx, const float* gvec, const float* modl, int sh_idx, int sc_idx, bf16* XN, int nrows) {
    f32x4 gq[4];
#pragma unroll
    for (int j = 0; j < 4; ++j) gq[j] = *(const f32x4*)(gvec + 4 * F.lane + 256 * j);
    for (int m = F.gw; m < nrows; m += F.NGW) {
        const float* xrow = (m < NLAT) ? src_lat + (size_t)m * DM : src_ctx + (size_t)(m - NLAT) * DM;
        const float* mr = modl + (size_t)((m < NLAT) ? (m >> 12) : 16) * 6144;
        f32x4 v[4]; float s = 0.f;
#pragma unroll
        for (int j = 0; j < 4; ++j) { v[j] = *(const f32x4*)(xrow + 4 * F.lane + 256 * j); s += (v[j].x * v[j].x + v[j].y * v[j].y) + (v[j].z * v[j].z + v[j].w * v[j].w); }
        const float rstd = rsqrtf(wave_sum(s) * (1.f / DM) + EPS);
        unsigned long long* o8 = (unsigned long long*)(XN + (size_t)m * DM) + F.lane;
#pragma unroll
        for (int j = 0; j < 4; ++j) { const f32x4 sh = *(const f32x4*)(mr + sh_idx * 1024 + 4 * F.lane + 256 * j), sc = *(const f32x4*)(mr + sc_idx * 1024 + 4 * F.lane + 256 * j);
            const f32x4 y = v[j] * rstd * gq[j] * (sc + 1.f) + sh;
            o8[64 * j] = (unsigned long long)pk2(y.x, y.y) | ((unsigned long long)pk2(y.z, y.w) << 32); }
    }
}
__device__ __forceinline__ void final_norm_phase(Frame& F, float* xio, const float* gvec) {
    f32x4 gq[4];
#pragma unroll
    for (int j = 0; j < 4; ++j) gq[j] = *(const f32x4*)(gvec + 4 * F.lane + 256 * j);
    for (int m = F.gw; m < NLAT; m += F.NGW) {
        float* xrow = xio + (size_t)m * DM;
        f32x4 v[4]; float s = 0.f;
#pragma unroll
        for (int j = 0; j < 4; ++j) { v[j] = *(const f32x4*)(xrow + 4 * F.lane + 256 * j); s += (v[j].x * v[j].x + v[j].y * v[j].y) + (v[j].z * v[j].z + v[j].w * v[j].w); }
        const float rstd = rsqrtf(wave_sum(s) * (1.f / DM) + EPS);
#pragma unroll
        for (int j = 0; j < 4; ++j) *(f32x4*)(xrow + 4 * F.lane + 256 * j) = v[j] * rstd * gq[j];
    }
}

__device__ __forceinline__ void ld16bf(const bf16* p, float (&v)[16]) {
    const v4u a = *(const v4u*)p, b = *(const v4u*)(p + 8);
    v[0] = bflo(a.x); v[1] = bfhi(a.x); v[2] = bflo(a.y); v[3] = bfhi(a.y); v[4] = bflo(a.z); v[5] = bfhi(a.z); v[6] = bflo(a.w); v[7] = bfhi(a.w);
    v[8] = bflo(b.x); v[9] = bfhi(b.x); v[10] = bflo(b.y); v[11] = bfhi(b.y); v[12] = bflo(b.z); v[13] = bfhi(b.z); v[14] = bflo(b.w); v[15] = bfhi(b.w);
}
__device__ __forceinline__ void st16bf(bf16* p, const float (&v)[16]) {
    v4u a, b; a.x = pk2(v[0], v[1]); a.y = pk2(v[2], v[3]); a.z = pk2(v[4], v[5]); a.w = pk2(v[6], v[7]); b.x = pk2(v[8], v[9]); b.y = pk2(v[10], v[11]); b.z = pk2(v[12], v[13]); b.w = pk2(v[14], v[15]);
    *(v4u*)p = a; *(v4u*)(p + 8) = b;
}

__device__ __forceinline__ void mixA_naive(Frame& F, kptr_t kp, int l, const bf16* Z, bf16* Y, int nunits) {
    LAS float* vt = (LAS float*)F.lds;
    const int p = F.tid >> 2, qd = F.tid & 3;
    for (int u = blockIdx.x; u < nunits; u += F.G) {
        const int ch = u >> 2, g = u & 3; const size_t row = (size_t)ch * 128 + p;
        float v[16]; ld16bf(Z + row * ZW + Z_AV + g * 64 + qd * 16, v);
        float s = 0.f;
#pragma unroll
        for (int i = 0; i < 16; ++i) { v[i] = gelu_tanh(v[i]); s += v[i]; }
        s += __shfl_xor(s, 1); s += __shfl_xor(s, 2);
        const float mu = s * (1.f / 64.f); float s2 = 0.f;
#pragma unroll
        for (int i = 0; i < 16; ++i) { v[i] -= mu; s2 += v[i] * v[i]; }
        s2 += __shfl_xor(s2, 1); s2 += __shfl_xor(s2, 2);
        const float rstd = rsqrtf(s2 * (1.f / 64.f) + EPS);
        const float* lg = KIN(I_ALNG) + (l * 4 + g) * 64 + qd * 16; const float* lb = KIN(I_ALNB) + (l * 4 + g) * 64 + qd * 16;
#pragma unroll
        for (int i = 0; i < 16; ++i) vt[p * 65 + qd * 16 + i] = v[i] * rstd * lg[i] + lb[i];
        __syncthreads();
        const float* wrow = KIN(I_AWS) + ((size_t)(l * 4 + g) * 128 + p) * 128;
        float acc[16];
#pragma unroll
        for (int i = 0; i < 16; ++i) acc[i] = 0.f;
        for (int q = 0; q < 128; ++q) { const float w = wrow[q];
#pragma unroll
            for (int i = 0; i < 16; ++i) acc[i] += w * vt[q * 65 + qd * 16 + i]; }
        const float bias = KIN(I_ABS)[(l * 4 + g) * 128 + p];
        float uu[16]; ld16bf(Z + row * ZW + Z_AU + g * 64 + qd * 16, uu);
#pragma unroll
        for (int i = 0; i < 16; ++i) uu[i] = gelu_tanh(uu[i]) * (acc[i] + bias);
        st16bf(Y + row * DM + Y_A + g * 64 + qd * 16, uu);
        __syncthreads();
    }
}

__device__ __forceinline__ float mixb_dot(const float (&q)[64], const bf16* kp_) {
    float d_ = 0.f;
#pragma unroll
    for (int c8 = 0; c8 < 8; ++c8) { const v4u kv = *(const v4u*)(kp_ + c8 * 8);
        d_ += q[c8 * 8 + 0] * bflo(kv.x) + q[c8 * 8 + 1] * bfhi(kv.x) + q[c8 * 8 + 2] * bflo(kv.y) + q[c8 * 8 + 3] * bfhi(kv.y) + q[c8 * 8 + 4] * bflo(kv.z) + q[c8 * 8 + 5] * bfhi(kv.z) + q[c8 * 8 + 6] * bflo(kv.w) + q[c8 * 8 + 7] * bfhi(kv.w); }
    return d_;
}
__device__ __forceinline__ void mixB_naive(Frame& F, kptr_t kp, int l, const bf16* Z, bf16* Y, bool ctx_out) {
    const int nlat = NB * 6 * 8, nctx = ctx_out ? NB * 3 : 0;
    for (int u = blockIdx.x; u < nlat + nctx; u += F.G) {
        int b, h; size_t qrow; const bool lat = u < nlat; int r = 0, c = 0;
        if (lat) { b = u / 48; h = (u / 8) % 6; r = (u % 8) * 8 + (F.tid >> 6); c = F.tid & 63; qrow = (size_t)b * SEQ + r * 64 + c; }
        else { const int v = u - nlat; b = v / 3; h = (v % 3) * 2 + (F.tid >> 8); qrow = (size_t)NLAT + b * CTXL + (F.tid & 255); }
        float q[64], o[64];
        { const bf16* qp = Z + qrow * ZW + Z_BQ + h * 64;
#pragma unroll
            for (int c8 = 0; c8 < 8; ++c8) { const v4u t = *(const v4u*)(qp + c8 * 8);
                q[c8 * 8 + 0] = 0.125f * bflo(t.x); q[c8 * 8 + 1] = 0.125f * bfhi(t.x); q[c8 * 8 + 2] = 0.125f * bflo(t.y); q[c8 * 8 + 3] = 0.125f * bfhi(t.y);
                q[c8 * 8 + 4] = 0.125f * bflo(t.z); q[c8 * 8 + 5] = 0.125f * bfhi(t.z); q[c8 * 8 + 6] = 0.125f * bflo(t.w); q[c8 * 8 + 7] = 0.125f * bfhi(t.w); } }
#pragma unroll
        for (int d = 0; d < 64; ++d) o[d] = 0.f;
        const int kr0 = min(max(r - 4, 0), 56), kc0 = min(max(c - 8, 0), 48);
        const float* rpb = KIN(I_RPB) + (size_t)(l * 6 + h) * 15 * 31;
        const int nwin = lat ? 128 : 0, crow0 = NLAT + b * CTXL;
        float m = -1e30f;
        for (int kk = 0; kk < nwin + 256; ++kk) {
            int krow; float bias = 0.f;
            if (kk < nwin) { const int i = kk >> 4, j = kk & 15; krow = b * SEQ + (kr0 + i) * 64 + kc0 + j; bias = rpb[(kr0 + i - r + 7) * 31 + (kc0 + j - c + 15)]; } else krow = crow0 + (kk - nwin);
            const float sc = mixb_dot(q, Z + (size_t)krow * ZW + Z_BK + h * 64) + bias;
            m = fmaxf(m, sc);
        }
        float lsum = 0.f;
        for (int kk = 0; kk < nwin + 256; ++kk) {
            int krow; float bias = 0.f;
            if (kk < nwin) { const int i = kk >> 4, j = kk & 15; krow = b * SEQ + (kr0 + i) * 64 + kc0 + j; bias = rpb[(kr0 + i - r + 7) * 31 + (kc0 + j - c + 15)]; } else krow = crow0 + (kk - nwin);
            const float sc = mixb_dot(q, Z + (size_t)krow * ZW + Z_BK + h * 64) + bias;
            const float p_ = __expf(sc - m); lsum += p_;
            const bf16* vp = Z + (size_t)krow * ZW + Z_BV + h * 64;
#pragma unroll
            for (int c8 = 0; c8 < 8; ++c8) { const v4u vv = *(const v4u*)(vp + c8 * 8);
                o[c8 * 8 + 0] += p_ * bflo(vv.x); o[c8 * 8 + 1] += p_ * bfhi(vv.x); o[c8 * 8 + 2] += p_ * bflo(vv.y); o[c8 * 8 + 3] += p_ * bfhi(vv.y); o[c8 * 8 + 4] += p_ * bflo(vv.z); o[c8 * 8 + 5] += p_ * bfhi(vv.z); o[c8 * 8 + 6] += p_ * bflo(vv.w); o[c8 * 8 + 7] += p_ * bfhi(vv.w); }
        }
        const float inv = 1.f / lsum;
        bf16* yp = Y + qrow * DM + Y_B + h * 64;
#pragma unroll
        for (int c8 = 0; c8 < 8; ++c8) { v4u w; w.x = pk2(o[c8 * 8 + 0] * inv, o[c8 * 8 + 1] * inv); w.y = pk2(o[c8 * 8 + 2] * inv, o[c8 * 8 + 3] * inv); w.z = pk2(o[c8 * 8 + 4] * inv, o[c8 * 8 + 5] * inv); w.w = pk2(o[c8 * 8 + 6] * inv, o[c8 * 8 + 7] * inv);
            *(v4u*)(yp + c8 * 8) = w; }
    }
}

__device__ __forceinline__ float qk_conv(const bf16* Z, const float* cw, const float* cb, size_t base, int t, int len, int which, int h, int d) {
    const int cc = which * 384 + h * 64 + d, zc = (which ? Z_CK : Z_CQ) + h * 64 + d;
    float s = cb[cc];
#pragma unroll
    for (int j = 0; j < 3; ++j) { const int tt = t + j - 1; if (tt >= 0 && tt < len) s += cw[j * 768 + cc] * bf2f(Z[(base + tt) * ZW + zc]); }
    return siluf_(s);
}
__device__ __forceinline__ void mixC_naive(Frame& F, kptr_t kp, int l, const bf16* Z, bf16* Y, float* HF, bool ctx_out) {
    LAS float* qs = (LAS float*)F.lds;
    LAS float* ks = qs + 4096;
    LAS float* vs = ks + 4096;
    LAS float* hb = vs + 4096;
    LAS float* red = hb + 4096;
    LAS float* rdn = red + 1024;
    LAS float* ei = rdn + 16;
    LAS float* ef = ei + 64;
    const float* cw = KIN(I_CONVW) + (size_t)l * 3 * 768; const float* cb = KIN(I_CONVB) + l * 768; const float* gb = KIN(I_GATEB) + l * 24;
    const int dv = F.tid & 63, kg = F.tid >> 6;
    for (int u = blockIdx.x; u < NB * 6; u += F.G) {
        const int b = u / 6, h = u % 6;
        for (int dir = 0; dir < 2; ++dir) {
            float C[8], nn[8];
#pragma unroll
            for (int i = 0; i < 8; ++i) { C[i] = 0.f; nn[i] = 0.f; }
            for (int bi = 0; bi < 68; ++bi) {
                const bool isctx = bi < 4; const int blk = isctx ? (dir ? 3 - bi : bi) : (dir ? 63 - (bi - 4) : bi - 4);
                const size_t sbase = isctx ? (size_t)NLAT + b * CTXL : (size_t)b * SEQ; const int slen = isctx ? CTXL : SEQ;
                for (int idx = F.tid; idx < 64 * 128; idx += NTHR) {
                    const int tt = idx >> 7, chn = idx & 127, which = chn >> 6, d = chn & 63, t = blk * 64 + tt;
                    float val = qk_conv(Z, cw, cb, sbase, t, slen, which, h, d);
                    if (!isctx) {
                        const int dd = d & 31, jf = dd & 15; const int pos = (d < 32) ? (t >> 6) : (t & 63);
                        const float ang = (float)pos * __powf(10000.f, -(float)jf * (1.f / 16.f)); float sn, cs; __sincosf(ang, &sn, &cs);
                        const float other = qk_conv(Z, cw, cb, sbase, t, slen, which, h, (dd < 16) ? d + 16 : d - 16);
                        val = (dd < 16) ? (val * cs - other * sn) : (other * sn + val * cs);
                    }
                    if (which) ks[tt * 64 + d] = val * 0.125f; else qs[tt * 64 + d] = val;
                }
                for (int idx = F.tid; idx < 64 * 64; idx += NTHR) { const int tt = idx >> 6, d = idx & 63; vs[idx] = bf2f(Z[(sbase + blk * 64 + tt) * ZW + Z_CV + h * 64 + d]); }
                if (F.tid < 64) { const bf16* zg = Z + (sbase + blk * 64 + F.tid) * ZW + Z_CG;
                    const float gi = bf2f(zg[(2 * dir) * 6 + h]) + gb[(2 * dir) * 6 + h], gf = bf2f(zg[(2 * dir + 1) * 6 + h]) + gb[(2 * dir + 1) * 6 + h];
                    ei[F.tid] = __expf(gi); ef[F.tid] = sigmoidf_(gf); }
                __syncthreads();
                for (int step = 0; step < 64; ++step) {
                    const int tt = dir ? 63 - step : step; const float f = ef[tt], iw = ei[tt], vv = vs[tt * 64 + dv];
                    float pn = 0.f, pd = 0.f;
#pragma unroll
                    for (int i = 0; i < 8; ++i) { const float kk = ks[tt * 64 + kg * 8 + i], qq = qs[tt * 64 + kg * 8 + i];
                        C[i] = f * C[i] + iw * kk * vv; nn[i] = f * nn[i] + iw * kk; pn += qq * C[i]; pd += qq * nn[i]; }
                    red[((step & 1) * 8 + kg) * 64 + dv] = pn; if (dv == 0) rdn[(step & 1) * 8 + kg] = pd;
                    __syncthreads();
                    if (F.tid < 64) { float num = 0.f, den = 0.f;
#pragma unroll
                        for (int g = 0; g < 8; ++g) { num += red[((step & 1) * 8 + g) * 64 + F.tid]; den += rdn[(step & 1) * 8 + g]; }
                        hb[tt * 64 + F.tid] = num / fmaxf(fabsf(den), 1.f); }
                }
                __syncthreads();
                if (!isctx || ctx_out) {
                    for (int idx = F.tid; idx < 64 * 64; idx += NTHR) { const int tt = idx >> 6, d = idx & 63; const size_t row = sbase + blk * 64 + tt;
                        if (dir == 0) HF[row * 384 + h * 64 + d] = hb[idx];
                        else { const float co = bf2f(Z[row * ZW + Z_CO + h * 64 + d]); const float y = (HF[row * 384 + h * 64 + d] + hb[idx]) * sigmoidf_(co);
                            Y[row * DM + Y_C + h * 64 + d] = (bf16)f2bf(y); } }
                }
                __syncthreads();
            }
        }
    }
}

#define PH_LO() (*(const int __attribute__((address_space(4)))*)(kp + 8 * 24))
#define PH_HI() (*(const int __attribute__((address_space(4)))*)(kp + 8 * 24 + 4))
__device__ __forceinline__ void frame_init(Frame& F, LAS unsigned char* lds) {
    int tid_l = threadIdx.x; asm volatile("" : "+v"(tid_l));
    F.lds = lds; F.tid = tid_l; F.lane = F.tid & 63; F.wave = __builtin_amdgcn_readfirstlane(F.tid >> 6);
    F.G = gridDim.x; F.gw = blockIdx.x * NWAVES + F.wave; F.NGW = F.G * NWAVES;
}
__global__ void __launch_bounds__(NTHR, 2) fwd_kernel(Args a_unused) {
    extern __shared__ __attribute__((aligned(16))) unsigned char lds_raw[];
    LAS unsigned char* const lds = (LAS unsigned char*)lds_raw;
    volatile LAS unsigned* MISC = (volatile LAS unsigned*)(lds + MISC_OFF);
    for (int u = threadIdx.x; u < (LDS_BYTES - LDSCTL_OFF) / 4; u += NTHR) ((LAS unsigned*)(lds + LDSCTL_OFF))[u] = 0u;
    __syncthreads();
    int lo, hi; XcdBarrier bar;
    { kptr_t kp = kargs(); lo = PH_LO(); hi = PH_HI(); unsigned* barw = (unsigned*)(KWS() + WS_CTL) + CW_BAR;
      bar.bar = barw; bar.x = 0; bar.st = nullptr;
      if (hi - lo > 1) bar = xcd_barrier_post(barw, MISC + 8); }
#define IN(k) (lo <= (k) && (k) < hi)
#define SEAM(k) do { if (IN(k) && IN((k) + 1)) xcd_barrier(bar); } while (0)

    if (IN(0)) { kptr_t kp = kargs(); Frame F; frame_init(F, lds); p0_prologue(F, kp); SEAM(0); }

    for (int l = 0; l < 2; ++l) {
        const int pb = 1 + 9 * l;
        if (IN(pb + 0)) { kptr_t kp = kargs(); Frame F; frame_init(F, lds);
            const float* rin_lat = (l == 0) ? KIN(I_X) : (const float*)KOUT(); const float* rin_ctx = (l == 0) ? KIN(I_CTX) : (const float*)(KWS() + WS_XRC);
            norm_mod_phase(F, rin_lat, rin_ctx, KIN(I_N1G) + l * DM, (const float*)(KWS() + WS_MOD) + (size_t)l * 17 * 6144, 0, 1, (bf16*)(KWS() + WS_XN), MROWS); SEAM(pb + 0); }
        if (IN(pb + 1)) { kptr_t kp = kargs();
            pg8::Gemm g{(const bf16*)(KWS() + WS_XN), (const bf16*)(KWS() + WS_WIN + l * WIN_BYTES), MROWS, ZW, DM}; pg8::StaticOrder S; S.init(MROWS, ZW, (int)gridDim.x, (int)blockIdx.x);
            pg8::EpiBf16<0> E{(bf16*)(KWS() + WS_Z), ZW, nullptr, 0, 0, 1.f};
            pg8::gemm_phase<pg8::EpiBf16<0>, pg8::StaticOrder, true, true>(lds, g, S, E);
            SEAM(pb + 1);
        }
        if (IN(pb + 2)) { kptr_t kp = kargs(); Frame F; frame_init(F, lds);
            const bool ctx_out = (l == 0); const int mrows = ctx_out ? MROWS : NLAT;
            const bf16* Z = (const bf16*)(KWS() + WS_Z); bf16* Y = (bf16*)(KWS() + WS_XN);
            mixA_naive(F, kp, l, Z, Y, (mrows / 128) * 4);
            __syncthreads();
            mixB_naive(F, kp, l, Z, Y, ctx_out);
            __syncthreads();
            mixC_naive(F, kp, l, Z, Y, (float*)(KWS() + WS_HF), ctx_out);
            SEAM(pb + 2);
        }
        if (IN(pb + 3)) { SEAM(pb + 3); }
        if (IN(pb + 4)) { SEAM(pb + 4); }
        if (IN(pb + 5)) { kptr_t kp = kargs();
            const int mrows = (l == 0) ? MROWS : NLAT;
            const float* rin_lat = (l == 0) ? KIN(I_X) : (const float*)KOUT(); const float* rin_ctx = (l == 0) ? KIN(I_CTX) : (const float*)(KWS() + WS_XRC);
            pg8::Gemm g{(const bf16*)(KWS() + WS_XN), (const bf16*)(KWS() + WS_WOUT + l * WOUT_BYTES), mrows, DM, DM}; pg8::StaticOrder S; S.init(mrows, DM, (int)gridDim.x, (int)blockIdx.x);
            pg8::EpiRes E{rin_lat, rin_ctx, KOUT(), (float*)(KWS() + WS_XRC), (const float*)(KWS() + WS_MOD) + (size_t)l * 17 * 6144, 2};
            pg8::gemm_phase<pg8::EpiRes, pg8::StaticOrder, true, true>(lds, g, S, E);
            SEAM(pb + 5);
        }
        if (IN(pb + 6)) { kptr_t kp = kargs(); Frame F; frame_init(F, lds);
            norm_mod_phase(F, KOUT(), (const float*)(KWS() + WS_XRC), KIN(I_N2G) + l * DM, (const float*)(KWS() + WS_MOD) + (size_t)l * 17 * 6144, 3, 4, (bf16*)(KWS() + WS_XN), (l == 0) ? MROWS : NLAT); SEAM(pb + 6); }
        if (IN(pb + 7)) { kptr_t kp = kargs();
            const int mrows = (l == 0) ? MROWS : NLAT;
            pg8::Gemm g{(const bf16*)(KWS() + WS_XN), (const bf16*)(KWS() + WS_WGU + l * WGU_BYTES), mrows, 2 * DFF, DM}; pg8::StaticOrder S; S.init(mrows, 2 * DFF, (int)gridDim.x, (int)blockIdx.x);
            pg8::EpiSwiGLU E{(bf16*)(KWS() + WS_Z)};
            pg8::gemm_phase<pg8::EpiSwiGLU, pg8::StaticOrder, true, true>(lds, g, S, E);
            SEAM(pb + 7);
        }
        if (IN(pb + 8)) { kptr_t kp = kargs();
            const int mrows = (l == 0) ? MROWS : NLAT;
            pg8::Gemm g{(const bf16*)(KWS() + WS_Z), (const bf16*)(KWS() + WS_WDN + l * WDN_BYTES), mrows, DM, DFF}; pg8::StaticOrder S; S.init(mrows, DM, (int)gridDim.x, (int)blockIdx.x);
            pg8::EpiRes E{KOUT(), (const float*)(KWS() + WS_XRC), KOUT(), (float*)(KWS() + WS_XRC), (const float*)(KWS() + WS_MOD) + (size_t)l * 17 * 6144, 5};
            pg8::gemm_phase<pg8::EpiRes, pg8::StaticOrder, true, true>(lds, g, S, E);
            SEAM(pb + 8);
        }
    }
    if (IN(19)) { kptr_t kp = kargs(); Frame F; frame_init(F, lds); final_norm_phase(F, KOUT(), KIN(I_FING)); }
#undef IN
#undef SEAM
}

#ifndef MK_ONE_LAUNCH
#define MK_ONE_LAUNCH 0
#endif
extern "C" void kernel_launch(void* const* d_in, const int* in_sizes, int n_in, void* d_out, int out_size, void* d_ws, size_t ws_size, hipStream_t stream) {
    static int grid = 0;
    if (grid == 0) {
        if (n_in != 22 || out_size != NLAT * DM || ws_size < WS_END) { fprintf(stderr, "kernel_launch: unexpected problem (n_in %d, out %d, ws %zu < %zu); nothing launched\n", n_in, out_size, ws_size, (size_t)WS_END); grid = -1; return; }
        int dev = 0, cus = 0, per_cu = 0;
        if (hipGetDevice(&dev) != hipSuccess || hipDeviceGetAttribute(&cus, hipDeviceAttributeMultiprocessorCount, dev) != hipSuccess) { grid = -1; return; }
        if (hipFuncSetAttribute((const void*)fwd_kernel, hipFuncAttributeMaxDynamicSharedMemorySize, LDS_BYTES) != hipSuccess) { fprintf(stderr, "kernel_launch: hipFuncSetAttribute failed\n"); grid = -1; return; }
        if (hipOccupancyMaxActiveBlocksPerMultiprocessor(&per_cu, (const void*)fwd_kernel, NTHR, LDS_BYTES) != hipSuccess || per_cu < 1) { fprintf(stderr, "kernel_launch: occupancy query reports %d blocks per CU\n", per_cu); }
        (void)hipGetLastError();
        grid = cus;
    }
    if (grid < 0) return;
    (void)hipMemsetAsync((char*)d_ws + WS_CTL, 0, CTL_ZERO_BYTES, stream);
    Args a{};
    for (int i = 0; i < 22; ++i) a.in[i] = (const float*)d_in[i];
    a.out = (float*)d_out; a.ws = (unsigned char*)d_ws;
#if MK_ONE_LAUNCH
    a.ph_lo = 0; a.ph_hi = NPHASE;
    hipLaunchKernelGGL(fwd_kernel, dim3(grid), dim3(NTHR), LDS_BYTES, stream, a);
#else
    for (int p = 0; p < NPHASE; ++p) {
        if (p >= 1 && p <= 18) { const int r = (p - 1) % 9; if (r == 3 || r == 4) continue; }
        a.ph_lo = p; a.ph_hi = p + 1;
        hipLaunchKernelGGL(fwd_kernel, dim3(grid), dim3(NTHR), LDS_BYTES, stream, a);
    }
#endif
}
```

```cpp
#include <hip/hip_runtime.h>
#include <cstdio>
#include <cstdint>

namespace pg8 {
#define PG8_LAS __attribute__((address_space(3)))
typedef unsigned short bf16_t;
typedef short bf16x8 __attribute__((ext_vector_type(8)));
typedef float f32x4 __attribute__((ext_vector_type(4)));
typedef unsigned u32x4 __attribute__((ext_vector_type(4)));
constexpr int BM = 256, BK = 64, HALF = 128, HTB = HALF * BK * 2  , STAGE_BYTES = 8 * HTB, NXCD = 8, WGM = 8;

__host__ __device__ __forceinline__ int lds_byte(int r, int c) { const int st = (r >> 4) * 2 + (c >> 5), rr = r & 15, cc = c & 31, ob = rr * 64 + cc * 2; return st * 1024 + (ob ^ (((ob >> 9) & 1) << 5)); }
__host__ __device__ __forceinline__ void stage_rc(int b, int& R, int& C) { const int st = b / 1024, sb = b % 1024, swz = sb ^ (((sb >> 9) & 1) << 5); R = (st >> 1) * 16 + swz / 64; C = (st & 1) * 32 + (swz % 64) / 2; }
__host__ __device__ __forceinline__ int perm32(int rho) { const int n = rho >> 4, i = rho & 15; return 8 * (i >> 2) + 4 * n + (i & 3); }

struct Unit { int pm, pn, slot; };
struct Gemm { const bf16_t* A; const bf16_t* Bt; int M, N, K; };
__host__ __device__ __forceinline__ size_t tiled_off(size_t row, int k, int K) { return (((row >> 8) * (size_t)(K >> 6) + (size_t)(k >> 6)) << 14) + ((row & 255) << 6) + (size_t)(k & 63); }

struct StaticOrder {
    int nM, nN, nwg, G, c;
    __host__ __device__ void init(int M, int N, int G_, int c_) { nM = M / BM; nN = N / BM; nwg = nM * nN; G = G_; c = c_; }
    __host__ __device__ bool next(int i, Unit& u) const {
        const long L = (long)i * G + c; if (L >= nwg) return false;
        int wgid = (int)L; { const int q = nwg / NXCD, r = nwg % NXCD, xcd = wgid % NXCD, off = wgid / NXCD; wgid = (xcd < r ? xcd * (q + 1) : r * (q + 1) + (xcd - r) * q) + off; }
        const int nig = WGM * nN, gid = wgid / nig, fm = gid * WGM, gsz = (nM - fm) < WGM ? (nM - fm) : WGM;
        u.pm = fm + ((wgid % nig) % gsz); u.pn = (wgid % nig) / gsz; return true;
    }
    __device__ __forceinline__ void a_ready(const Unit&) const {}
    __device__ __forceinline__ void done(const Unit&) const {}
};


typedef float f32x2c __attribute__((ext_vector_type(2))); typedef __bf16 bf16x2c __attribute__((ext_vector_type(2)));
__device__ __forceinline__ unsigned cvt_pk_bf16(float lo, float hi) { const f32x2c v = {lo, hi}; const bf16x2c b = __builtin_convertvector(v, bf16x2c); return __builtin_bit_cast(unsigned, b); }
typedef float f32x2 __attribute__((ext_vector_type(2)));
__device__ __forceinline__ f32x2 gelu_pk(f32x2 v) {
    const f32x2 av = __builtin_elementwise_abs(v), d = av * 0.2316418882f + 1.0f;
    f32x2 t; t.x = __builtin_amdgcn_rcpf(d.x); t.y = __builtin_amdgcn_rcpf(d.y);
    f32x2 q = t * 0.5307027145f + (-0.7265760135f); q = q * t + 0.7107068705f; q = q * t + (-0.142248368f); q = q * t + 0.127414796f; q = q * t;
    const f32x2 s = (v * v) * (-0.72134752044f);
    f32x2 e; e.x = __builtin_amdgcn_exp2f(s.x); e.y = __builtin_amdgcn_exp2f(s.y);
    const f32x2 m = v * (q * e), r = v - m;
    f32x2 o; o.x = v.x < 0.f ? m.x : r.x; o.y = v.y < 0.f ? m.y : r.y; return o;
}

template <int ACT  > struct EpiBf16 {
    static constexpr bool PERM = true, AFTER_DRAIN = false; static_assert(ACT == 0 || ACT == 1, "EpiBf16: ACT is 0 (none) or 1 (gelu_pk)");
    bf16_t* O; int ldc; const float* bias; int split_cols; size_t split_stride; float scale0;
    __device__ __forceinline__ void operator()(const f32x4 (&acc)[2][2][4][2], const Unit& u, int wr, int wc, int fr, int fq) const {
        const int row0 = u.pm * BM + wr * 64 + fr; int colt = u.pn * BM; bf16_t* base = O;
        float sc = 1.f; if (split_cols) { const int t = colt / split_cols; base += (size_t)t * split_stride; colt -= t * split_cols; if (t == 0) sc = scale0; }
        const int col0 = colt + wc * 32 + 8 * fq, bcol0 = u.pn * BM + wc * 32 + 8 * fq;
        f32x4 bv[2][2];
#pragma unroll
        for (int bj = 0; bj < 2; ++bj)
#pragma unroll
            for (int n = 0; n < 2; ++n) bv[bj][n] = bias ? *(const f32x4*)(bias + bcol0 + bj * HALF + 4 * n) : (f32x4){0.f, 0.f, 0.f, 0.f};
#pragma unroll
        for (int ai = 0; ai < 2; ++ai)
#pragma unroll
            for (int m = 0; m < 4; ++m) { bf16_t* rowp = base + (size_t)(row0 + ai * HALF + m * 16) * ldc + col0;
#pragma unroll
                for (int bj = 0; bj < 2; ++bj) { f32x4 v0 = acc[ai][bj][m][0] + bv[bj][0], v1 = acc[ai][bj][m][1] + bv[bj][1];
                    if (ACT == 1) { f32x2 a = gelu_pk((f32x2){v0[0], v0[1]}), b = gelu_pk((f32x2){v0[2], v0[3]}), c = gelu_pk((f32x2){v1[0], v1[1]}), d = gelu_pk((f32x2){v1[2], v1[3]});
                        v0 = (f32x4){a.x, a.y, b.x, b.y}; v1 = (f32x4){c.x, c.y, d.x, d.y}; }
                    v0 = v0 * sc; v1 = v1 * sc; u32x4 w; w.x = cvt_pk_bf16(v0[0], v0[1]); w.y = cvt_pk_bf16(v0[2], v0[3]); w.z = cvt_pk_bf16(v1[0], v1[1]); w.w = cvt_pk_bf16(v1[2], v1[3]);
                    *(u32x4*)(rowp + bj * HALF) = w; } }
    }
};


template <class Epi, class Sched, bool ALIGN_EPI = false, bool SP2 = false>
__device__ __forceinline__ void gemm_phase(PG8_LAS unsigned char* lds, const Gemm g, const Sched& S, const Epi& E) {
    int tid_l = threadIdx.x; asm volatile("" : "+v"(tid_l));
    const int tid = tid_l, wid = __builtin_amdgcn_readfirstlane(tid >> 6), lane = tid & 63, wr = wid >> 2, wc = wid & 3, fr = lane & 15, fq = lane >> 4;
    const int K = g.K, nt = K / BK;
    unsigned voffA[2], voffB[2];
#pragma unroll
    for (int i = 0; i < 2; ++i) { int R, C; stage_rc(tid * 16 + i * 8192, R, C); const int Rb = Epi::PERM ? ((R & ~31) + perm32(R & 31)) : R;
        voffA[i] = (unsigned)(R * BK + C) * 2u; voffB[i] = (unsigned)(Rb * BK + C) * 2u; }
    const size_t kstep = (size_t)(BM * BK * 2);
    const size_t hstep = (size_t)HALF * BK * 2;
    const size_t tstep = (size_t)(K / BK) * kstep;
    const unsigned ldsw = (unsigned)wid * 1024u;
    const int aoff = lds_byte(wr * 64 + fr, fq * 8), boff = lds_byte(wc * 32 + fr, fq * 8);
#define PG8_SA(b, h) (((b) * 2 + (h)) * HTB)
#define PG8_SB(b, h) ((4 + (b) * 2 + (h)) * HTB)
#define PG8_STAGE(bufoff, gbase, voff) do { _Pragma("unroll") for (int _i = 0; _i < 2; ++_i) \
        __builtin_amdgcn_global_load_lds((const unsigned*)((const char*)(gbase) + (voff)[_i]), (PG8_LAS unsigned*)(lds + (bufoff) + ldsw + _i * 8192), 16, 0, 0); } while (0)
#define PG8_LDA(dst, b, h) do { _Pragma("unroll") for (int m = 0; m < 4; ++m) _Pragma("unroll") for (int k = 0; k < 2; ++k) dst[m][k] = *(const PG8_LAS bf16x8*)(lds + PG8_SA(b, h) + aoff + m * 2048 + k * 1024); } while (0)
#define PG8_LDB(dst, b, h) do { _Pragma("unroll") for (int n = 0; n < 2; ++n) _Pragma("unroll") for (int k = 0; k < 2; ++k) dst[n][k] = *(const PG8_LAS bf16x8*)(lds + PG8_SB(b, h) + boff + n * 2048 + k * 1024); } while (0)
#define PG8_MMA(ai, bj, At, Bt) do { __builtin_amdgcn_s_setprio(1); _Pragma("unroll") for (int m = 0; m < 4; ++m) _Pragma("unroll") for (int n = 0; n < 2; ++n) _Pragma("unroll") for (int k = 0; k < 2; ++k) \
        acc[ai][bj][m][n] = __builtin_amdgcn_mfma_f32_16x16x32_bf16(Bt[n][k], At[m][k], acc[ai][bj][m][n], 0, 0, 0); __builtin_amdgcn_s_setprio(0); } while (0)
#define PG8_WAIT_V(n) asm volatile("s_waitcnt vmcnt(" #n ")" ::: "memory")
#define PG8_WAIT_L(n) asm volatile("s_waitcnt lgkmcnt(" #n ")" ::: "memory")
#define PG8_BAR __builtin_amdgcn_s_barrier()
#define PG8_SCHED __builtin_amdgcn_sched_barrier(0)
    Unit cur, nxt; int ui = 0;
    if (!S.next(0, cur)) return;
    cur.slot = 0;
    f32x4 acc[2][2][4][2];
#pragma unroll
    for (int a = 0; a < 2; ++a)
#pragma unroll
        for (int b = 0; b < 2; ++b)
#pragma unroll
            for (int m = 0; m < 4; ++m)
#pragma unroll
                for (int n = 0; n < 2; ++n) acc[a][b][m][n] = (f32x4){0.f, 0.f, 0.f, 0.f};
    bf16x8 At[4][2], B0[2][2], B1[2][2];
    const char* cA = (const char*)g.A + (size_t)cur.pm * tstep; const char* cB = (const char*)g.Bt + (size_t)cur.pn * tstep;
    S.a_ready(cur);
    if constexpr (SP2) {
        PG8_STAGE(PG8_SB(0, 0), cB, voffB); PG8_STAGE(PG8_SB(0, 1), cB + hstep, voffB); PG8_STAGE(PG8_SA(0, 0), cA, voffA); PG8_STAGE(PG8_SA(0, 1), cA + hstep, voffA);
        if (wr == 1) PG8_BAR;
        PG8_WAIT_V(2); PG8_BAR;
        PG8_STAGE(PG8_SB(1, 0), cB + kstep, voffB); PG8_STAGE(PG8_SA(1, 0), cA + kstep, voffA); PG8_STAGE(PG8_SB(1, 1), cB + hstep + kstep, voffB);
        PG8_WAIT_V(6); PG8_BAR;
    } else {
        PG8_STAGE(PG8_SB(0, 0), cB, voffB); PG8_STAGE(PG8_SA(0, 0), cA, voffA); PG8_STAGE(PG8_SB(0, 1), cB + hstep, voffB); PG8_STAGE(PG8_SA(0, 1), cA + hstep, voffA);
        if (wr == 1) PG8_BAR;
        PG8_WAIT_V(4); PG8_BAR;
        PG8_STAGE(PG8_SB(1, 0), cB + kstep, voffB); PG8_STAGE(PG8_SA(1, 0), cA + kstep, voffA); PG8_STAGE(PG8_SB(1, 1), cB + hstep + kstep, voffB);
        PG8_WAIT_V(6); PG8_BAR;
    }
    for (;;) {
        const bool has_next = S.next(ui + 1, nxt); nxt.slot = (ui + 1) & 1;
        const char* nA = has_next ? (const char*)g.A + (size_t)nxt.pm * tstep : cA; const char* nB = has_next ? (const char*)g.Bt + (size_t)nxt.pn * tstep : cB;
        for (int t = 0; t < nt; t += 2) {
            const bool last = (t == nt - 2);
            const char* a1 = cA + (size_t)(t + 1) * kstep;
            const char* a2 = last ? nA : cA + (size_t)(t + 2) * kstep; const char* b2 = last ? nB : cB + (size_t)(t + 2) * kstep;
            const char* a3 = a2 + kstep; const char* b3 = b2 + kstep;
            if (last && has_next) S.a_ready(nxt);
            if constexpr (SP2) {
            PG8_LDB(B0, 0, 0); PG8_LDB(B1, 0, 1); PG8_SCHED; PG8_LDA(At, 0, 0); PG8_STAGE(PG8_SA(1, 1), a1 + hstep, voffA);
            PG8_WAIT_V(8); PG8_WAIT_L(0); PG8_BAR; PG8_MMA(0, 0, At, B0); PG8_MMA(0, 1, At, B1); PG8_BAR; PG8_SCHED;
            PG8_LDA(At, 0, 1); PG8_STAGE(PG8_SB(0, 0), b2, voffB); PG8_STAGE(PG8_SB(0, 1), b2 + hstep, voffB); PG8_STAGE(PG8_SA(0, 0), a2, voffA);
            PG8_WAIT_V(8); PG8_WAIT_L(0); PG8_BAR; PG8_MMA(1, 0, At, B0); PG8_MMA(1, 1, At, B1); PG8_BAR; PG8_SCHED;
            PG8_LDB(B0, 1, 0); PG8_LDB(B1, 1, 1); PG8_SCHED; PG8_LDA(At, 1, 0); PG8_STAGE(PG8_SA(0, 1), a2 + hstep, voffA);
            PG8_WAIT_V(8); PG8_WAIT_L(0); PG8_BAR; PG8_MMA(0, 0, At, B0); PG8_MMA(0, 1, At, B1); PG8_BAR; PG8_SCHED;
            PG8_LDA(At, 1, 1); PG8_STAGE(PG8_SB(1, 0), b3, voffB); PG8_STAGE(PG8_SB(1, 1), b3 + hstep, voffB); PG8_STAGE(PG8_SA(1, 0), a3, voffA);
            PG8_WAIT_V(8); PG8_WAIT_L(0); PG8_BAR; PG8_MMA(1, 0, At, B0); PG8_MMA(1, 1, At, B1); PG8_BAR; PG8_SCHED;
            } else {
            PG8_LDB(B0, 0, 0); PG8_SCHED; PG8_LDA(At, 0, 0); PG8_STAGE(PG8_SA(1, 1), a1 + hstep, voffA);
            PG8_WAIT_L(8); PG8_BAR; PG8_WAIT_L(0); PG8_MMA(0, 0, At, B0); PG8_BAR; PG8_SCHED;
            PG8_LDB(B1, 0, 1); PG8_STAGE(PG8_SB(0, 0), b2, voffB);
            PG8_BAR; PG8_WAIT_L(0); PG8_MMA(0, 1, At, B1); PG8_BAR;
            PG8_LDA(At, 0, 1); PG8_STAGE(PG8_SA(0, 0), a2, voffA);
            PG8_BAR; PG8_WAIT_L(0); PG8_MMA(1, 0, At, B0); PG8_BAR; PG8_SCHED;
            PG8_STAGE(PG8_SB(0, 1), b2 + hstep, voffB);
            PG8_WAIT_V(6); PG8_BAR; PG8_MMA(1, 1, At, B1); PG8_BAR;
            PG8_LDB(B0, 1, 0); PG8_SCHED; PG8_LDA(At, 1, 0); PG8_STAGE(PG8_SA(0, 1), a2 + hstep, voffA);
            PG8_WAIT_L(8); PG8_BAR; PG8_WAIT_L(0); PG8_MMA(0, 0, At, B0); PG8_BAR; PG8_SCHED;
            PG8_LDB(B1, 1, 1); PG8_STAGE(PG8_SB(1, 0), b3, voffB);
            PG8_BAR; PG8_WAIT_L(0); PG8_MMA(0, 1, At, B1); PG8_BAR;
            PG8_LDA(At, 1, 1); PG8_STAGE(PG8_SA(1, 0), a3, voffA);
            PG8_BAR; PG8_WAIT_L(0); PG8_MMA(1, 0, At, B0); PG8_BAR; PG8_SCHED;
            PG8_STAGE(PG8_SB(1, 1), b3 + hstep, voffB);
            PG8_WAIT_V(6); PG8_BAR; PG8_MMA(1, 1, At, B1); PG8_BAR;
            }
        }
        if constexpr (ALIGN_EPI) { if (wr == 0) PG8_BAR; }
        if constexpr (!Epi::AFTER_DRAIN) { E(acc, cur, wr, wc, fr, fq); S.done(cur); }
        if (!has_next) break;
#pragma unroll
        for (int a = 0; a < 2; ++a)
#pragma unroll
            for (int b = 0; b < 2; ++b)
#pragma unroll
                for (int m = 0; m < 4; ++m)
#pragma unroll
                    for (int n = 0; n < 2; ++n) acc[a][b][m][n] = (f32x4){0.f, 0.f, 0.f, 0.f};
        cur = nxt; cA = nA; cB = nB; ++ui;
        if constexpr (ALIGN_EPI) { if (wr == 1) PG8_BAR; }
    }
    PG8_WAIT_V(0);
    if constexpr (!ALIGN_EPI) { if (wr == 0) PG8_BAR; }
    PG8_BAR;
    if constexpr (Epi::AFTER_DRAIN) { E.fused(acc, cur, wr, wc, fr, fq, lds, wid, lane); S.done(cur); }
#undef PG8_SA
#undef PG8_SB
#undef PG8_STAGE
#undef PG8_LDA
#undef PG8_LDB
#undef PG8_MMA
#undef PG8_WAIT_V
#undef PG8_WAIT_L
#undef PG8_BAR
#undef PG8_SCHED
}
}
#define GAS __attribute__((address_space(1)))
#define LAS __attribute__((address_space(3)))
typedef unsigned short bf16;
typedef unsigned v4u __attribute__((ext_vector_type(4)));
typedef float f32x4 __attribute__((ext_vector_type(4)));
typedef short bf16x8 __attribute__((ext_vector_type(8)));
typedef GAS unsigned gu32;
typedef GAS unsigned long long gu64;
#define RLX_AGENT __ATOMIC_RELAXED, __HIP_MEMORY_SCOPE_AGENT
#define LDS_WAIT() asm volatile("s_waitcnt lgkmcnt(0)" ::: "memory")
#define VM_WAIT() asm volatile("s_waitcnt vmcnt(0)" ::: "memory")
__device__ __forceinline__ unsigned long long rt() { return __builtin_amdgcn_s_memrealtime(); }
__device__ __forceinline__ unsigned f2bf(float f) { unsigned u = __builtin_bit_cast(unsigned, f); return (u + 0x7fffu + ((u >> 16) & 1u)) >> 16; }
typedef float f32x2_t __attribute__((ext_vector_type(2))); typedef __bf16 bf16x2_t __attribute__((ext_vector_type(2)));
__device__ __forceinline__ unsigned pk2(float lo, float hi) { const f32x2_t v = {lo, hi}; const bf16x2_t b = __builtin_convertvector(v, bf16x2_t); return __builtin_bit_cast(unsigned, b); }

#define XB_TMO      128
#define XB_XCNT(j)  (256  + 64 * (j))
#define XB_XSUB(j)  (1280 + 64 * (j))
#define XB_XGEN(j)  (2304 + 64 * (j))
#define XB_TOP      3328
#define XB_TOPGEN   3392
#define XCD_BAR_WORDS 3456
#define XB_SPIN_CAP (1u << 24)

__device__ __forceinline__ unsigned xb_ld(unsigned* p)              { return __hip_atomic_load(p, __ATOMIC_RELAXED, __HIP_MEMORY_SCOPE_AGENT); }
__device__ __forceinline__ unsigned xb_add(unsigned* p, unsigned v) { return __hip_atomic_fetch_add(p, v, __ATOMIC_RELAXED, __HIP_MEMORY_SCOPE_AGENT); }
__device__ __forceinline__ unsigned xb_xcc_id() { return (unsigned)__builtin_amdgcn_s_getreg((3 << 11) | 20) & 0xFu; }
#define XB_SPIN(cond, bar) do { unsigned _sp = 0; while (cond) { __builtin_amdgcn_s_sleep(1); \
    if ((++_sp & 255u) == 0u) { if (xb_ld(&(bar)[XB_TMO])) break; if (_sp > XB_SPIN_CAP) { atomicAdd(&(bar)[XB_TMO], 1u); break; } } } } while (0)

struct XcdBarrier {
    unsigned* bar; unsigned x;
    volatile LAS unsigned* st;
};

__device__ __forceinline__ XcdBarrier xcd_barrier_post(unsigned* bar, volatile LAS unsigned* st) {
    XcdBarrier b; b.bar = bar; b.x = xb_xcc_id(); b.st = st;
    if (threadIdx.x == 0) (void)xb_add(&bar[XB_XCNT(b.x)], 1u);
    return b;
}
__device__ __forceinline__ void xcd_barrier_complete(unsigned* bar, unsigned x, unsigned& nloc, unsigned& nx) {
    const unsigned G = gridDim.x * gridDim.y * gridDim.z;
    unsigned sum, cnt, mine, sp = 0u;
    for (;;) {
        sum = 0u; cnt = 0u; mine = 0u;
#pragma unroll
        for (unsigned j = 0; j < 16; ++j) { const unsigned c = xb_ld(&bar[XB_XCNT(j)]); sum += c; cnt += (c > 0u) ? 1u : 0u; mine = (j == x) ? c : mine; }
        if (sum == G) break;
        __builtin_amdgcn_s_sleep(1);
        if ((++sp & 255u) == 0u) { if (xb_ld(&bar[XB_TMO])) break; if (sp > XB_SPIN_CAP) { atomicAdd(&bar[XB_TMO], 1u); break; } }
    }
    nloc = mine > 0u ? mine : 1u; nx = cnt > 0u ? cnt : 1u;
}

__device__ __forceinline__ void xcd_barrier(const XcdBarrier& b) {
    asm volatile("s_waitcnt vmcnt(0)" ::: "memory");
    __syncthreads();
    if (threadIdx.x == 0) {
        unsigned* bar = b.bar;
        __builtin_amdgcn_s_waitcnt(0);
        unsigned nloc = b.st[0], nx = b.st[1];
        if (nloc == 0u) { xcd_barrier_complete(bar, b.x, nloc, nx); b.st[0] = nloc; b.st[1] = nx; }
        const unsigned old = xb_add(&bar[XB_XSUB(b.x)], 1u);
        const unsigned gen = old / nloc;
        if (old + 1u == (gen + 1u) * nloc) {
            __builtin_amdgcn_fence(__ATOMIC_RELEASE, "agent");
            asm volatile("s_waitcnt vmcnt(0)" ::: "memory");
            const unsigned og = xb_add(&bar[XB_TOP], 1u);
            const unsigned tg = og / nx;
            if (og + 1u == (tg + 1u) * nx) xb_add(&bar[XB_TOPGEN], 1u);
            else XB_SPIN(xb_ld(&bar[XB_TOPGEN]) == tg, bar);
            __builtin_amdgcn_fence(__ATOMIC_ACQUIRE, "agent");
            xb_add(&bar[XB_XGEN(b.x)], 1u);
            asm volatile("s_waitcnt vmcnt(0)" ::: "memory");
        } else {
            XB_SPIN(xb_ld(&bar[XB_XGEN(b.x)]) == gen, bar);
            __builtin_amdgcn_fence(__ATOMIC_ACQUIRE, "agent");
            asm volatile("s_waitcnt vmcnt(0)" ::: "memory");
        }
    }
    __syncthreads();
}

constexpr int DM = 1024, NB = 16, SEQ = 4096, CTXL = 256;
constexpr int NLAT = NB * SEQ;
constexpr int NCTX = NB * CTXL;
constexpr int MROWS = NLAT + NCTX;
constexpr int INC = 3224, ZW = 3328, DFF = 2816;
constexpr int Z_AU = 0, Z_AV = 256, Z_BQ = 512, Z_BK = 896, Z_BV = 1280, Z_CQ = 1664, Z_CK = 2048, Z_CV = 2432, Z_CO = 2816, Z_CG = 3200;
constexpr int Y_A = 0, Y_B = 256, Y_C = 640;
constexpr float EPS = 1e-6f;
constexpr int NWAVES = 8, NTHR = 512;

constexpr size_t MiB = 1u << 20;
constexpr size_t WS_CTL = 0, CTL_ZERO_BYTES = 65536;
constexpr size_t WS_MOD = 1 * MiB;
constexpr size_t WS_CV1 = 2 * MiB;
constexpr size_t WS_CV2 = WS_CV1 + (size_t)2 * 17 * 3328 * 4;
constexpr size_t WS_RSQ = 4 * MiB;
constexpr size_t WIN_BYTES = (size_t)3328 * 1024 * 2, WOUT_BYTES = (size_t)1024 * 1024 * 2, WGU_BYTES = (size_t)2 * 2816 * 1024 * 2, WDN_BYTES = (size_t)1024 * 2816 * 2;
constexpr size_t WS_WIN = 6 * MiB;
constexpr size_t WS_WOUT = WS_WIN + 2 * WIN_BYTES;
constexpr size_t WS_WGU = WS_WOUT + 2 * WOUT_BYTES;
constexpr size_t WS_WDN = WS_WGU + 2 * WGU_BYTES;
constexpr size_t WS_XN = WS_WDN + 2 * WDN_BYTES;
constexpr size_t WS_Z = WS_XN + (size_t)69632 * 1024 * 2;
constexpr size_t WS_RB = WS_Z + (size_t)69632 * 3328 * 2;
constexpr size_t WS_QP = WS_RB + (size_t)69632 * 1024 * 2;
constexpr size_t WS_A2 = WS_QP;
static_assert(WS_CV2 + (size_t)2 * 17 * 5632 * 4 <= WS_RSQ && WS_RSQ + (size_t)5 * 69632 * 4 <= WS_WIN && WS_XN == 56 * MiB && WS_Z == 192 * MiB && WS_RB == 634 * MiB && WS_QP == 770 * MiB, "d_ws map");
constexpr int CW_BAR = 4096;

constexpr int RING_BYTES = 131072;
constexpr int LDSCTL_OFF = RING_BYTES, MISC_OFF = LDSCTL_OFF + 320;
constexpr int PRE_OFF = LDSCTL_OFF + 1024;
constexpr int LDS_BYTES = 147456;


__device__ __forceinline__ float bflo(unsigned u) { return __uint_as_float(u << 16); }
__device__ __forceinline__ float bfhi(unsigned u) { return __uint_as_float(u & 0xffff0000u); }
__device__ __forceinline__ float bf2f(bf16 v) { return __uint_as_float(((unsigned)v) << 16); }
__device__ __forceinline__ float sigmoidf_(float x) { return __builtin_amdgcn_rcpf(1.f + __expf(-x)); }
__device__ __forceinline__ float siluf_(float x) { return x * __builtin_amdgcn_rcpf(1.f + __expf(-x)); }
__device__ __forceinline__ float gelu_tanh(float x) { const float u = 0.7978845608028654f * (x + 0.044715f * x * x * x); return x * __builtin_amdgcn_rcpf(1.f + __expf(-2.f * u)); }
__device__ __forceinline__ float wave_sum(float v) {
#pragma unroll
    for (int o = 1; o < 64; o <<= 1) v += __shfl_xor(v, o);
    return v;
}

namespace pg8 {
__device__ __forceinline__ int unit_batch(const Unit& u) { return u.pm < 256 ? (u.pm >> 4) : 16; }
struct PrefOrder : StaticOrder {
    const float* rv; const float* cv; int cvn; PG8_LAS unsigned char* pre;
    __device__ __forceinline__ void a_ready(const Unit& u) const {
        const int wid = __builtin_amdgcn_readfirstlane(threadIdx.x >> 6), lane = threadIdx.x & 63;
        const float* src = (wid < 4) ? rv + (size_t)u.pm * 256 + wid * 64 + lane : cv + (size_t)unit_batch(u) * cvn + (size_t)u.pn * 256 + (wid - 4) * 64 + lane;
        __builtin_amdgcn_global_load_lds((const unsigned*)src, (PG8_LAS unsigned*)(pre + u.slot * 2048 + wid * 256), 4, 0, 0);
    }
};
__device__ __forceinline__ void unpack8f(const u32x4 t, float (&v)[8]) {
    v[0] = __uint_as_float(t.x << 16); v[1] = __uint_as_float(t.x & 0xffff0000u); v[2] = __uint_as_float(t.y << 16); v[3] = __uint_as_float(t.y & 0xffff0000u);
    v[4] = __uint_as_float(t.z << 16); v[5] = __uint_as_float(t.z & 0xffff0000u); v[6] = __uint_as_float(t.w << 16); v[7] = __uint_as_float(t.w & 0xffff0000u); }
struct EpiZH {
    static constexpr bool PERM = true, AFTER_DRAIN = false;
    bf16_t* ZH; int M; PG8_LAS unsigned char* pre;
    __device__ __forceinline__ void operator()(const f32x4 (&acc)[2][2][4][2], const Unit& u, int wr, int wc, int fr, int fq) const {
        const int row0 = u.pm * BM + wr * 64 + fr; const PG8_LAS float* pv = (const PG8_LAS float*)(pre + u.slot * 2048);
        float rstd[2][4];
#pragma unroll
        for (int ai = 0; ai < 2; ++ai)
#pragma unroll
            for (int m = 0; m < 4; ++m) rstd[ai][m] = __builtin_amdgcn_rsqf(pv[wr * 64 + fr + ai * HALF + m * 16] * (1.f / 1024.f) + 1e-6f);
#pragma unroll
        for (int bj = 0; bj < 2; ++bj) { const int colbase = u.pn * BM + bj * HALF + wc * 32;
            const f32x4 c0 = *(const PG8_LAS f32x4*)(pv + 256 + bj * HALF + wc * 32 + 8 * fq), c1 = *(const PG8_LAS f32x4*)(pv + 256 + bj * HALF + wc * 32 + 8 * fq + 4);
            bf16_t* base = ZH + ((size_t)(colbase >> 6) * M + row0) * 64 + (colbase & 63) + 8 * fq;
#pragma unroll
            for (int ai = 0; ai < 2; ++ai)
#pragma unroll
                for (int m = 0; m < 4; ++m) { const f32x4 v0 = acc[ai][bj][m][0] * rstd[ai][m] + c0, v1 = acc[ai][bj][m][1] * rstd[ai][m] + c1;
                    u32x4 w; w.x = cvt_pk_bf16(v0[0], v0[1]); w.y = cvt_pk_bf16(v0[2], v0[3]); w.z = cvt_pk_bf16(v1[0], v1[1]); w.w = cvt_pk_bf16(v1[2], v1[3]);
                    *(u32x4*)(base + (size_t)(ai * HALF + m * 16) * 64) = w; } }
    }
};
struct EpiSwiGLU {
    static constexpr bool PERM = true, AFTER_DRAIN = false;
    bf16_t* H; PG8_LAS unsigned char* pre;
    __device__ __forceinline__ void operator()(const f32x4 (&acc)[2][2][4][2], const Unit& u, int wr, int wc, int fr, int fq) const {
        const int row0 = u.pm * BM + wr * 64 + fr, col0 = u.pn * HALF + wc * 32 + 8 * fq; const PG8_LAS float* pv = (const PG8_LAS float*)(pre + u.slot * 2048);
        const PG8_LAS float* cvb = pv + 256 + wc * 32 + 8 * fq;
        const f32x4 cg0 = *(const PG8_LAS f32x4*)cvb, cg1 = *(const PG8_LAS f32x4*)(cvb + 4), cu0 = *(const PG8_LAS f32x4*)(cvb + HALF), cu1 = *(const PG8_LAS f32x4*)(cvb + HALF + 4);
#pragma unroll
        for (int ai = 0; ai < 2; ++ai)
#pragma unroll
            for (int m = 0; m < 4; ++m) { const int row = row0 + ai * HALF + m * 16; const float rstd = __builtin_amdgcn_rsqf(pv[wr * 64 + fr + ai * HALF + m * 16] * (1.f / 1024.f) + 1e-6f);
                const f32x4 g0 = acc[ai][0][m][0] * rstd + cg0, g1 = acc[ai][0][m][1] * rstd + cg1, p0 = acc[ai][1][m][0] * rstd + cu0, p1 = acc[ai][1][m][1] * rstd + cu1;
                const f32x4 t0 = g0 * -1.4426950408889634f, t1 = g1 * -1.4426950408889634f;
                f32x4 e0, e1;
#pragma unroll
                for (int j = 0; j < 4; ++j) { e0[j] = __builtin_amdgcn_exp2f(t0[j]); e1[j] = __builtin_amdgcn_exp2f(t1[j]); }
                const f32x4 d0 = e0 + 1.f, d1 = e1 + 1.f;
                f32x4 r0, r1;
#pragma unroll
                for (int j = 0; j < 4; ++j) { r0[j] = __builtin_amdgcn_rcpf(d0[j]); r1[j] = __builtin_amdgcn_rcpf(d1[j]); }
                const f32x4 h0 = (g0 * p0) * r0, h1 = (g1 * p1) * r1;
                u32x4 w; w.x = cvt_pk_bf16(h0[0], h0[1]); w.y = cvt_pk_bf16(h0[2], h0[3]); w.z = cvt_pk_bf16(h1[0], h1[1]); w.w = cvt_pk_bf16(h1[2], h1[3]);
                *(u32x4*)(H + tiled_off((size_t)row, col0, 2816)) = w; }
    }
};
__device__ __forceinline__ f32x4 gsafe4(f32x4 v) {
#pragma unroll
    for (int j = 0; j < 4; ++j) v[j] = (__builtin_fabsf(v[j]) < 1e-20f) ? 1e-20f : v[j];
    return v;
}
__device__ __forceinline__ f32x4 rcp4(f32x4 v) { f32x4 r; r[0] = __builtin_amdgcn_rcpf(v[0]); r[1] = __builtin_amdgcn_rcpf(v[1]); r[2] = __builtin_amdgcn_rcpf(v[2]); r[3] = __builtin_amdgcn_rcpf(v[3]); return r; }
struct EpiRes {
    static constexpr bool PERM = true, AFTER_DRAIN = false;
    const bf16_t* Rt; const float* rgn; const float* rscl;
    bf16_t* Aout; const float* ogn; const float* oscl;
    bf16_t* Fout;
    float* rsq; const float* gate;
    __device__ __forceinline__ void operator()(const f32x4 (&acc)[2][2][4][2], const Unit& u, int wr, int wc, int fr, int fq) const {
        const int b = unit_batch(u), row0 = u.pm * BM + wr * 64 + fr;
        float rs[2][4];
#pragma unroll
        for (int ai = 0; ai < 2; ++ai)
#pragma unroll
            for (int m = 0; m < 4; ++m) rs[ai][m] = 0.f;
#pragma unroll
        for (int bj = 0; bj < 2; ++bj) { const int col0 = u.pn * BM + bj * HALF + wc * 32 + 8 * fq; const size_t bo = (size_t)b * 6144 + col0;
            const f32x4 ga = *(const f32x4*)(gate + bo), gb = *(const f32x4*)(gate + bo + 4);
            f32x4 sa = {0.f, 0.f, 0.f, 0.f}, sb = sa, ia = sa, ib = sa;
            if (ogn) { sa = gsafe4(*(const f32x4*)(ogn + col0) * (*(const f32x4*)(oscl + bo) + 1.f)); sb = gsafe4(*(const f32x4*)(ogn + col0 + 4) * (*(const f32x4*)(oscl + bo + 4) + 1.f)); }
            { ia = rcp4(gsafe4(*(const f32x4*)(rgn + col0) * (*(const f32x4*)(rscl + bo) + 1.f))); ib = rcp4(gsafe4(*(const f32x4*)(rgn + col0 + 4) * (*(const f32x4*)(rscl + bo + 4) + 1.f))); }
#define EPIRES_ROW(ai, m, r0, r1) do { const int row_ = row0 + (ai) * HALF + (m) * 16; \
                const f32x4 x0 = (r0) + ga * acc[ai][bj][m][0], x1 = (r1) + gb * acc[ai][bj][m][1]; \
                rs[ai][m] += (x0[0] * x0[0] + x0[1] * x0[1]) + (x0[2] * x0[2] + x0[3] * x0[3]) + (x1[0] * x1[0] + x1[1] * x1[1]) + (x1[2] * x1[2] + x1[3] * x1[3]); \
                if (ogn) { const f32x4 y0 = x0 * sa, y1 = x1 * sb; u32x4 q_; q_.x = cvt_pk_bf16(y0[0], y0[1]); q_.y = cvt_pk_bf16(y0[2], y0[3]); q_.z = cvt_pk_bf16(y1[0], y1[1]); q_.w = cvt_pk_bf16(y1[2], y1[3]); \
                    *(u32x4*)(Aout + tiled_off((size_t)row_, col0, 1024)) = q_; } \
                else { u32x4 w_; w_.x = cvt_pk_bf16(x0[0], x0[1]); w_.y = cvt_pk_bf16(x0[2], x0[3]); w_.z = cvt_pk_bf16(x1[0], x1[1]); w_.w = cvt_pk_bf16(x1[2], x1[3]); *(u32x4*)(Fout + (size_t)row_ * 1024 + col0) = w_; } } while (0)
            {
#pragma unroll
                for (int ai = 0; ai < 2; ++ai)
#pragma unroll
                    for (int m = 0; m < 4; m += 2) { const u32x4 q0 = *(const u32x4*)(Rt + tiled_off((size_t)(row0 + ai * HALF + m * 16), col0, 1024)), q1 = *(const u32x4*)(Rt + tiled_off((size_t)(row0 + ai * HALF + m * 16 + 16), col0, 1024));
                        { float t[8]; unpack8f(q0, t); const f32x4 r0 = (f32x4){t[0], t[1], t[2], t[3]} * ia, r1 = (f32x4){t[4], t[5], t[6], t[7]} * ib; EPIRES_ROW(ai, m, r0, r1); }
                        { float t[8]; unpack8f(q1, t); const f32x4 r0 = (f32x4){t[0], t[1], t[2], t[3]} * ia, r1 = (f32x4){t[4], t[5], t[6], t[7]} * ib; EPIRES_ROW(ai, m + 1, r0, r1); }
                        asm volatile("" ::: "memory"); }
            }
#undef EPIRES_ROW
        }
#pragma unroll
        for (int ai = 0; ai < 2; ++ai) {
#pragma unroll
            for (int m = 0; m < 4; ++m) { float v = rs[ai][m]; v += __shfl_xor(v, 16); v += __shfl_xor(v, 32); rs[ai][m] = v; }
            const float v = fq == 0 ? rs[ai][0] : fq == 1 ? rs[ai][1] : fq == 2 ? rs[ai][2] : rs[ai][3];
            atomicAdd(rsq + row0 + ai * HALF + fq * 16, v); }
    }
};
}

struct SmallRes { const bf16* Rt; const float* rgn; const float* rscl; bf16* Aout; const float* ogn; const float* oscl; float* rsq; const float* gate; };
__device__ __forceinline__ void ctx_small_gemm(LAS unsigned char* lds, int tid_, const bf16* A, const bf16* Bt, int K, const SmallRes E) {
    typedef short sbf16x8 __attribute__((ext_vector_type(8)));
    constexpr int TS = 144, STG = (64 + 256) * TS;
    const int lane = tid_ & 63, w = __builtin_amdgcn_readfirstlane(tid_ >> 6), r = lane & 15, g = lane >> 4, nkt = K >> 6;
    for (int qu = blockIdx.x; qu < 16 * 4 * 4; qu += gridDim.x) {
        const int pmc = qu >> 4, pn = (qu >> 2) & 3, rq = qu & 3;
        const size_t row_base = (size_t)NLAT + pmc * 256 + rq * 64;
        const bf16* Ap = A + pg8::tiled_off(row_base, 0, K);
        const bf16* Bp = Bt + pg8::tiled_off((size_t)pn * 256, 0, K);
        v4u ra, rb[4];
#define SG_LOAD(kt) do { ra = *(const v4u*)(Ap + (size_t)(kt) * 16384 + tid_ * 8); _Pragma("unroll") for (int i = 0; i < 4; ++i) rb[i] = *(const v4u*)(Bp + (size_t)(kt) * 16384 + (tid_ + 512 * i) * 8); } while (0)
#define SG_STORE(st) do { LAS unsigned char* sb_ = lds + (st) * STG; *(LAS v4u*)(sb_ + (tid_ >> 3) * TS + (tid_ & 7) * 16) = ra; \
        _Pragma("unroll") for (int i = 0; i < 4; ++i) { const int e_ = tid_ + 512 * i; *(LAS v4u*)(sb_ + 64 * TS + (e_ >> 3) * TS + (e_ & 7) * 16) = rb[i]; } } while (0)
        f32x4 acc[4][2];
#pragma unroll
        for (int mt = 0; mt < 4; ++mt)
#pragma unroll
            for (int nt = 0; nt < 2; ++nt) acc[mt][nt] = (f32x4){0.f, 0.f, 0.f, 0.f};
        SG_LOAD(0); SG_STORE(0);
        __syncthreads();
        for (int kt = 0; kt < nkt; ++kt) {
            if (kt + 1 < nkt) SG_LOAD(kt + 1);
            LAS const unsigned char* sa = lds + (kt & 1) * STG; LAS const unsigned char* sbb = sa + 64 * TS;
#pragma unroll
            for (int ks = 0; ks < 2; ++ks) {
                sbf16x8 af[4], bfr[2];
#pragma unroll
                for (int mt = 0; mt < 4; ++mt) af[mt] = *(LAS const sbf16x8*)(sa + (16 * mt + r) * TS + g * 16 + ks * 64);
#pragma unroll
                for (int nt = 0; nt < 2; ++nt) bfr[nt] = *(LAS const sbf16x8*)(sbb + (32 * w + 16 * nt + r) * TS + g * 16 + ks * 64);
#pragma unroll
                for (int mt = 0; mt < 4; ++mt)
#pragma unroll
                    for (int nt = 0; nt < 2; ++nt) acc[mt][nt] = __builtin_amdgcn_mfma_f32_16x16x32_bf16(bfr[nt], af[mt], acc[mt][nt], 0, 0, 0);
            }
            if (kt + 1 < nkt) SG_STORE((kt + 1) & 1);
            __syncthreads();
        }
#undef SG_LOAD
#undef SG_STORE
#pragma unroll
        for (int mt = 0; mt < 4; ++mt) { const size_t row = row_base + 16 * mt + r; float rs = 0.f;
#pragma unroll
            for (int nt = 0; nt < 2; ++nt) { const int col = pn * 256 + 32 * w + 16 * nt + 4 * g; const size_t ro = row * 1024 + col;
                f32x4 res;
                { const unsigned long long t = *(const unsigned long long*)(E.Rt + pg8::tiled_off(row, col, 1024)); const unsigned lo = (unsigned)t, hi = (unsigned)(t >> 32);
                    res = (f32x4){bflo(lo), bfhi(lo), bflo(hi), bfhi(hi)} * pg8::rcp4(pg8::gsafe4(*(const f32x4*)(E.rgn + col) * (*(const f32x4*)(E.rscl + col) + 1.f))); }
                const f32x4 x = res + *(const f32x4*)(E.gate + col) * acc[mt][nt];
                rs += (x[0] * x[0] + x[1] * x[1]) + (x[2] * x[2] + x[3] * x[3]);
                { const f32x4 y = x * pg8::gsafe4(*(const f32x4*)(E.ogn + col) * (*(const f32x4*)(E.oscl + col) + 1.f));
                    *(unsigned long long*)(E.Aout + pg8::tiled_off(row, col, 1024)) = (unsigned long long)pk2(y[0], y[1]) | ((unsigned long long)pk2(y[2], y[3]) << 32); } }
            rs += __shfl_xor(rs, 16); rs += __shfl_xor(rs, 32);
            if (g == 0) atomicAdd(E.rsq + row, rs); }
        __syncthreads();
    }
}

struct Args { const float* in[22]; float* out; unsigned char* ws; int ph_lo, ph_hi; };
static_assert(sizeof(Args) == 22 * 8 + 8 + 8 + 8, "Args has no padding");
enum { I_X = 0, I_C, I_CTX, I_CCTX, I_WMOD, I_BMOD, I_N1G, I_WIN, I_ALNG, I_ALNB, I_AWS, I_ABS, I_RPB, I_CONVW, I_CONVB, I_GATEB, I_WOUT, I_N2G, I_WGATE, I_WUP, I_WDOWN, I_FING };
constexpr int NPHASE = 17;
typedef const __attribute__((address_space(4))) unsigned char* kptr_t;
__device__ __forceinline__ kptr_t kargs() { kptr_t p = (kptr_t)__builtin_amdgcn_kernarg_segment_ptr(); asm volatile("" : "+s"(p)); return p; }
#define KIN(i) (*(const float* const __attribute__((address_space(4)))*)(kp + 8 * (i)))
#define KOUT() (*(float* const __attribute__((address_space(4)))*)(kp + 8 * 22))
#define KWS() (*(unsigned char* const __attribute__((address_space(4)))*)(kp + 8 * 23))

struct Frame {
    LAS unsigned char* lds;
    int tid, lane, wave, G, gw, NGW;
};

__device__ __forceinline__ void p0_transpose_item(const float* W, int K, int N, bf16* WT, int nblk, int item, LAS float* scr, int lane, int grp, int gstride, int goff) {
    const int kb = item / nblk, nb = item % nblk, k0 = 64 * kb, n0 = 32 * nb;
    const int nn = n0 + (lane & 31);
#pragma unroll 8
    for (int i = 0; i < 32; ++i) { const int kk = 2 * i + (lane >> 5); scr[kk * 33 + (lane & 31)] = (nn < N) ? W[(size_t)(k0 + kk) * N + nn] : 0.f; }
    LDS_WAIT(); asm volatile("" ::: "memory");
    const int c = lane & 7;
#pragma unroll
    for (int j = 0; j < 4; ++j) { const int n = (lane >> 3) + 8 * j; const LAS float* s = scr + (8 * c) * 33 + n;
        v4u o; o.x = pk2(s[0 * 33], s[1 * 33]); o.y = pk2(s[2 * 33], s[3 * 33]); o.z = pk2(s[4 * 33], s[5 * 33]); o.w = pk2(s[6 * 33], s[7 * 33]);
        const int sn = n0 + n; const int dr = grp ? (sn / grp) * gstride + goff + sn % grp : sn;
        *(GAS v4u*)(WT + pg8::tiled_off((size_t)dr, k0 + 8 * c, K)) = o; }
    LDS_WAIT(); asm volatile("" ::: "memory");
}

__device__ __forceinline__ void p0_prologue(Frame& F, kptr_t kp) {
    { float* rz = (float*)(KWS() + WS_RSQ) + MROWS; for (int i = F.gw * 64 + F.lane; i < 4 * MROWS; i += F.NGW * 64) rz[i] = 0.f; }
    {
        LAS float* scr = (LAS float*)(F.lds + F.wave * 16384);
        constexpr int I_IN = 16 * (ZW / 32), I_OUT = 16 * 32, I_G = 16 * (DFF / 32), I_D = (DFF / 64) * 32, PER_L = I_IN + I_OUT + 2 * I_G + I_D;
        for (int it = F.gw; it < 2 * PER_L; it += F.NGW) {
            const int l = it / PER_L; int r = it % PER_L;
            if (r < I_IN) { p0_transpose_item(KIN(I_WIN) + (size_t)l * DM * INC, DM, INC, (bf16*)(KWS() + WS_WIN + l * WIN_BYTES), ZW / 32, r, scr, F.lane, 0, 0, 0); continue; } r -= I_IN;
            if (r < I_OUT) { p0_transpose_item(KIN(I_WOUT) + (size_t)l * DM * DM, DM, DM, (bf16*)(KWS() + WS_WOUT + l * WOUT_BYTES), 32, r, scr, F.lane, 0, 0, 0); continue; } r -= I_OUT;
            if (r < I_G) { p0_transpose_item(KIN(I_WGATE) + (size_t)l * DM * DFF, DM, DFF, (bf16*)(KWS() + WS_WGU + l * WGU_BYTES), DFF / 32, r, scr, F.lane, 128, 256, 0); continue; } r -= I_G;
            if (r < I_G) { p0_transpose_item(KIN(I_WUP) + (size_t)l * DM * DFF, DM, DFF, (bf16*)(KWS() + WS_WGU + l * WGU_BYTES), DFF / 32, r, scr, F.lane, 128, 256, 128); continue; } r -= I_G;
            p0_transpose_item(KIN(I_WDOWN) + (size_t)l * DFF * DM, DFF, DM, (bf16*)(KWS() + WS_WDN + l * WDN_BYTES), 32, r, scr, F.lane, 0, 0, 0);
        }
    }
    __syncthreads();
    if ((int)blockIdx.x < 192) {
        LAS float* sc = (LAS float*)F.lds;
        LAS float* part = (LAS float*)(F.lds + 17 * 1024 * 4);
        for (int i = F.tid; i < 17 * 1024; i += NTHR) { const int b = i >> 10, k = i & 1023; const float v = (b < 16) ? KIN(I_C)[b * 1024 + k] : KIN(I_CCTX)[k]; sc[i] = siluf_(v); }
        __syncthreads();
        float* MOD = (float*)(KWS() + WS_MOD);
        for (int unit = blockIdx.x; unit < 192; unit += F.G) {
            const int l = unit / 96, slab = unit % 96, cc = F.tid & 63, kq = F.tid >> 6;
            const float* wp = KIN(I_WMOD) + ((size_t)l * 1024 + kq * 128) * 6144 + slab * 64 + cc;
            float acc[17];
#pragma unroll
            for (int b = 0; b < 17; ++b) acc[b] = 0.f;
#pragma unroll 4
            for (int k = 0; k < 128; ++k) { const float w = wp[(size_t)k * 6144];
#pragma unroll
                for (int b = 0; b < 17; ++b) acc[b] += sc[b * 1024 + kq * 128 + k] * w; }
#pragma unroll
            for (int b = 0; b < 17; ++b) part[(kq * 17 + b) * 64 + cc] = acc[b];
            __syncthreads();
            for (int i = F.tid; i < 17 * 64; i += NTHR) { const int b = i >> 6, c2 = i & 63; float s = KIN(I_BMOD)[l * 6144 + slab * 64 + c2];
#pragma unroll
                for (int q = 0; q < 8; ++q) s += part[(q * 17 + b) * 64 + c2];
                MOD[((size_t)l * 17 + b) * 6144 + slab * 64 + c2] = s; }
            __syncthreads();
        }
    }
}

__device__ __forceinline__ void ld16bf(const bf16* p, float (&v)[16]) {
    const v4u a = *(const v4u*)p, b = *(const v4u*)(p + 8);
    v[0] = bflo(a.x); v[1] = bfhi(a.x); v[2] = bflo(a.y); v[3] = bfhi(a.y); v[4] = bflo(a.z); v[5] = bfhi(a.z); v[6] = bflo(a.w); v[7] = bfhi(a.w);
    v[8] = bflo(b.x); v[9] = bfhi(b.x); v[10] = bflo(b.y); v[11] = bfhi(b.y); v[12] = bflo(b.z); v[13] = bfhi(b.z); v[14] = bflo(b.w); v[15] = bfhi(b.w);
}
__device__ __forceinline__ void st16bf(bf16* p, const float (&v)[16]) {
    v4u a, b; a.x = pk2(v[0], v[1]); a.y = pk2(v[2], v[3]); a.z = pk2(v[4], v[5]); a.w = pk2(v[6], v[7]); b.x = pk2(v[8], v[9]); b.y = pk2(v[10], v[11]); b.z = pk2(v[12], v[13]); b.w = pk2(v[14], v[15]);
    *(v4u*)p = a; *(v4u*)(p + 8) = b;
}


__device__ __forceinline__ void ld_row(const float* p, int lane, f32x4 (&v)[4]) {
#pragma unroll
    for (int j = 0; j < 4; ++j) v[j] = *(const f32x4*)(p + 4 * lane + 256 * j);
}
__device__ __forceinline__ float row_sumsq(const f32x4 (&v)[4]) {
    float s = 0.f;
#pragma unroll
    for (int j = 0; j < 4; ++j) s += (v[j].x * v[j].x + v[j].y * v[j].y) + (v[j].z * v[j].z + v[j].w * v[j].w);
    return wave_sum(s);
}
__device__ __forceinline__ void p1_phase(Frame& F, kptr_t kp) {
    unsigned char* ws = KWS();
    const float* MOD = (const float*)(ws + WS_MOD);
    {
        const int set = blockIdx.x & 3, l = set >> 1; const bool second = set & 1; const int NR = second ? 5632 : 3328;
        constexpr int SHS = 2064;
        const float* sh = MOD + (size_t)l * 17 * 6144 + (second ? 3 : 0) * 1024;
        for (int i = F.tid; i < 32 * 128; i += NTHR) { const int b = i >> 7, c8 = i & 127; v4u o = {0u, 0u, 0u, 0u};
            if (b < 17) { const f32x4 p = *(const f32x4*)(sh + (size_t)b * 6144 + c8 * 8), q = *(const f32x4*)(sh + (size_t)b * 6144 + c8 * 8 + 4); o.x = pk2(p.x, p.y); o.y = pk2(p.z, p.w); o.z = pk2(q.x, q.y); o.w = pk2(q.z, q.w); }
            *(LAS v4u*)(F.lds + b * SHS + c8 * 16) = o; }
        __syncthreads();
        const bf16* WT = (const bf16*)(ws + (second ? WS_WGU + l * WGU_BYTES : WS_WIN + l * WIN_BYTES));
        float* dst = (float*)(ws + (second ? WS_CV2 : WS_CV1)) + (size_t)l * 17 * NR;
        const int r = F.lane & 15, g = F.lane >> 4;
        for (int task = (blockIdx.x >> 2) * NWAVES + F.wave; task < NR / 16; task += (F.G >> 2) * NWAVES) {
            const bf16* wp = WT + pg8::tiled_off((size_t)(task * 16 + r), g * 8, 1024);
            f32x4 acc0 = {0.f, 0.f, 0.f, 0.f}, acc1 = acc0;
#pragma unroll 8
            for (int ks = 0; ks < 32; ++ks) { const pg8::bf16x8 a = *(const pg8::bf16x8*)(wp + (size_t)(ks >> 1) * 16384 + (ks & 1) * 32);
                const pg8::bf16x8 b0 = *(LAS const pg8::bf16x8*)(F.lds + r * SHS + g * 16 + ks * 64), b1 = *(LAS const pg8::bf16x8*)(F.lds + (16 + r) * SHS + g * 16 + ks * 64);
                acc0 = __builtin_amdgcn_mfma_f32_16x16x32_bf16(a, b0, acc0, 0, 0, 0); acc1 = __builtin_amdgcn_mfma_f32_16x16x32_bf16(a, b1, acc1, 0, 0, 0); }
            *(f32x4*)(dst + (size_t)r * NR + task * 16 + 4 * g) = acc0;
            if (r == 0) *(f32x4*)(dst + (size_t)16 * NR + task * 16 + 4 * g) = acc1;
        }
        __syncthreads();
    }
    {
        const float* src_lat = KIN(I_X); const float* src_ctx = KIN(I_CTX); const float* gvec = KIN(I_N1G); bf16* A1 = (bf16*)(ws + WS_XN); float* rsq0 = (float*)(ws + WS_RSQ);
        const int R = (MROWS + F.NGW - 1) / F.NGW, Re = (R + 1) & ~1, r0 = F.gw * Re, r1 = min(r0 + Re, MROWS);
        if (r0 >= r1) return;
        f32x4 gq[4], gs[4];
#pragma unroll
        for (int j = 0; j < 4; ++j) gq[j] = *(const f32x4*)(gvec + 4 * F.lane + 256 * j);
#define NM_ROWP(m) (((m) < NLAT) ? src_lat + (size_t)(m) * DM : src_ctx + (size_t)((m) - NLAT) * DM)
        f32x4 a[4], c[4], na[4], nc[4]; int bcur = -1;
        ld_row(NM_ROWP(r0), F.lane, a); ld_row(NM_ROWP(r0 + 1), F.lane, c);
        for (int m = r0; m < r1; m += 2) {
            const bool more = m + 2 < r1;
            if (more) { ld_row(NM_ROWP(m + 2), F.lane, na); ld_row(NM_ROWP(m + 3), F.lane, nc); }
            const int b = (m < NLAT) ? (m >> 12) : 16;
            if (b != bcur) { bcur = b; const float* mr = MOD + (size_t)b * 6144 + 1 * 1024;
#pragma unroll
                for (int j = 0; j < 4; ++j) gs[j] = pg8::gsafe4(gq[j] * (*(const f32x4*)(mr + 4 * F.lane + 256 * j) + 1.f)); }
            const float qa = row_sumsq(a), qc = row_sumsq(c);
            if (F.lane == 0) { rsq0[m] = qa; rsq0[m + 1] = qc; }
#pragma unroll
            for (int j = 0; j < 4; ++j) { const f32x4 y = a[j] * gs[j], z = c[j] * gs[j];
                *(unsigned long long*)(A1 + pg8::tiled_off((size_t)m, 4 * F.lane + 256 * j, DM)) = (unsigned long long)pk2(y.x, y.y) | ((unsigned long long)pk2(y.z, y.w) << 32);
                *(unsigned long long*)(A1 + pg8::tiled_off((size_t)m + 1, 4 * F.lane + 256 * j, DM)) = (unsigned long long)pk2(z.x, z.y) | ((unsigned long long)pk2(z.z, z.w) << 32); }
            if (more) {
#pragma unroll
                for (int j = 0; j < 4; ++j) { a[j] = na[j]; c[j] = nc[j]; } }
        }
#undef NM_ROWP
    }
}
__device__ __forceinline__ void final_norm_phase(Frame& F, kptr_t kp) {
    unsigned char* ws = KWS(); const bf16* RB = (const bf16*)(ws + WS_RB); const float* rsq = (const float*)(ws + WS_RSQ) + (size_t)4 * MROWS; float* out = KOUT(); const float* gvec = KIN(I_FING);
    const int R = (NLAT + F.NGW - 1) / F.NGW, Re = (R + 3) & ~3, r0 = F.gw * Re, r1 = min(r0 + Re, NLAT);
    if (r0 >= r1) return;
    f32x4 g0[2], g1[2];
#pragma unroll
    for (int p = 0; p < 2; ++p) { g0[p] = *(const f32x4*)(gvec + 512 * p + 8 * F.lane); g1[p] = *(const f32x4*)(gvec + 512 * p + 8 * F.lane + 4); }
    for (int m = r0; m < r1; m += 4) {
        v4u t[4][2]; float rq[4];
#pragma unroll
        for (int i = 0; i < 4; ++i) { rq[i] = rsq[m + i];
#pragma unroll
            for (int p = 0; p < 2; ++p) t[i][p] = *(const v4u*)(RB + (size_t)(m + i) * DM + 512 * p + 8 * F.lane); }
#pragma unroll
        for (int i = 0; i < 4; ++i) { const float rstd = __builtin_amdgcn_rsqf(rq[i] * (1.f / DM) + EPS);
#pragma unroll
            for (int p = 0; p < 2; ++p) { const v4u q = t[i][p]; float* op = out + (size_t)(m + i) * DM + 512 * p + 8 * F.lane;
                *(f32x4*)op = (f32x4){bflo(q.x), bfhi(q.x), bflo(q.y), bfhi(q.y)} * rstd * g0[p]; *(f32x4*)(op + 4) = (f32x4){bflo(q.z), bfhi(q.z), bflo(q.w), bfhi(q.w)} * rstd * g1[p]; } }
    }
}


typedef short mbf16x8 __attribute__((ext_vector_type(8)));
typedef short ms16x4 __attribute__((ext_vector_type(4)));
constexpr int TS64 = 144, TS128 = 272;
constexpr int G_AU = 0, G_AV = 4, G_BQ = 8, G_BK = 14, G_BV = 20, G_CQ = 26, G_CK = 32, G_CV = 38, G_CO = 44, G_CG = 50;
__device__ __forceinline__ const bf16* zh(const bf16* ZH, int grp, size_t row) { return ZH + ((size_t)grp * MROWS + row) * 64; }
template <int KS> __device__ __forceinline__ f32x4 mma16(LAS const unsigned char* ap, LAS const unsigned char* bp, f32x4 acc) {
#pragma unroll
    for (int ks = 0; ks < KS; ++ks) { const mbf16x8 a = *(LAS const mbf16x8*)(ap + ks * 64), b = *(LAS const mbf16x8*)(bp + ks * 64); acc = __builtin_amdgcn_mfma_f32_16x16x32_bf16(a, b, acc, 0, 0, 0); }
    return acc;
}
__device__ __forceinline__ ms16x4 lds_tr4(LAS const unsigned char* p) { return __builtin_bit_cast(ms16x4, __builtin_amdgcn_ds_read_tr16_b64_v4i16((LAS ms16x4*)p)); }
__device__ __forceinline__ unsigned short f2bfs(float f) { return (unsigned short)(pk2(f, 0.f) & 0xffffu); }
__device__ __forceinline__ void unpack8(const v4u t, float (&v)[8]) { v[0] = bflo(t.x); v[1] = bfhi(t.x); v[2] = bflo(t.y); v[3] = bfhi(t.y); v[4] = bflo(t.z); v[5] = bfhi(t.z); v[6] = bflo(t.w); v[7] = bfhi(t.w); }

constexpr size_t WS_KP = WS_QP + (size_t)MROWS * 384 * 2;
constexpr size_t WS_ST = WS_KP + (size_t)MROWS * 384 * 2;
constexpr size_t WS_SN = WS_ST + (size_t)192 * 68 * 4096 * 2;
constexpr size_t WS_GS = WS_SN + (size_t)192 * 68 * 64 * 4;
constexpr size_t WS_CUMG = WS_GS + (size_t)192 * 68 * 4 + 4096;
constexpr size_t WS_LIGG = WS_CUMG + (size_t)192 * 68 * 64 * 4;
constexpr size_t WS_END2 = WS_LIGG + (size_t)192 * 68 * 64 * 4;
static_assert(WS_END2 <= 1024 * MiB && WS_A2 + (size_t)MROWS * DM * 2 <= WS_END2, "d_ws map (mixers)");

__device__ __forceinline__ size_t chunk_row0(int b, int cs) { return cs < 4 ? (size_t)NLAT + b * CTXL + cs * 64 : (size_t)b * SEQ + (cs - 4) * 64; }
__device__ __forceinline__ float lane_shfl(float v, int src) { return __int_as_float(__builtin_amdgcn_ds_bpermute(src << 2, __float_as_int(v))); }
__device__ __forceinline__ float logsigmoidf_(float x) { return fminf(x, 0.f) - __logf(1.f + __expf(-fabsf(x))); }

__device__ __forceinline__ mbf16x8 trfrag(LAS const unsigned char* tile, int k0, int m0, int lane) {
    const int r = lane & 15, g = lane >> 4;
    LAS const unsigned char* p = tile + (k0 + 4 * g + (r >> 2)) * TS64 + (m0 + 4 * (r & 3)) * 2;
    const ms16x4 lo = lds_tr4(p), hi = lds_tr4(p + 16 * TS64);
    return (mbf16x8){lo[0], lo[1], lo[2], lo[3], hi[0], hi[1], hi[2], hi[3]};
}

struct C1Pref { v4u z[6]; v4u v; unsigned short gir, gfr; float gbi, gbf; int okm; };
__device__ __forceinline__ void c1_prefetch(C1Pref& P, const bf16* Z, const float* gb, int tid, int b, int h, int cs) {
    const bool isctx = cs < 4; const size_t row0 = chunk_row0(b, cs); const int t0 = isctx ? cs * 64 : (cs - 4) * 64, slen = isctx ? CTXL : SEQ;
    const size_t seq0 = isctx ? (size_t)NLAT + b * CTXL : (size_t)b * SEQ;
    const int tt = tid >> 3, which = (tid >> 2) & 1, qtr = tid & 3, t = t0 + tt;
    const int zg_ = (which ? G_CK : G_CQ) + h, zo_ = (qtr >> 1) * 32 + (qtr & 1) * 8;
    int okm = 0;
#pragma unroll
    for (int j = 0; j < 3; ++j) { const int ts = t + j - 1; const bool ok = ts >= 0 && ts < slen; const bf16* zp = zh(Z, zg_, seq0 + (ok ? ts : t)) + zo_;
        P.z[2 * j] = *(const v4u*)zp; P.z[2 * j + 1] = *(const v4u*)(zp + 16); okm |= ok ? (1 << j) : 0; }
    P.okm = okm;
    P.v = *(const v4u*)(zh(Z, G_CV + h, row0 + (tid >> 3)) + (tid & 7) * 8);
    if (tid < 128) { const int dir = tid >> 6; const bf16* zg = zh(Z, G_CG, row0 + (tid & 63));
        P.gir = *(const unsigned short*)(zg + (2 * dir) * 6 + h); P.gfr = *(const unsigned short*)(zg + (2 * dir + 1) * 6 + h); P.gbi = gb[(2 * dir) * 6 + h]; P.gbf = gb[(2 * dir + 1) * 6 + h]; }
}
__device__ __forceinline__ mbf16x8 scale_frag(mbf16x8 f, LAS const float* aw, int k0, int g) {
    const f32x4 s0 = *(LAS const f32x4*)(aw + k0 + 4 * g), s1 = *(LAS const f32x4*)(aw + k0 + 16 + 4 * g);
    float x[8]; unpack8(__builtin_bit_cast(v4u, f), x);
    v4u o; o.x = pk2(x[0] * s0[0], x[1] * s0[1]); o.y = pk2(x[2] * s0[2], x[3] * s0[3]); o.z = pk2(x[4] * s1[0], x[5] * s1[1]); o.w = pk2(x[6] * s1[2], x[7] * s1[3]);
    return __builtin_bit_cast(mbf16x8, o);
}
template <int SH>
__device__ __forceinline__ float row_shr_add(float v) {
    return v + __builtin_bit_cast(float, __builtin_amdgcn_update_dpp(0, __builtin_bit_cast(int, v), 0x110 + SH, 0xf, 0xf, false));
}
__device__ __forceinline__ float wave_incl_scan(float x, int lane, float& tot) {
    x = row_shr_add<1>(x); x = row_shr_add<2>(x); x = row_shr_add<4>(x); x = row_shr_add<8>(x);
    const float r0 = __builtin_bit_cast(float, __builtin_amdgcn_readlane(__builtin_bit_cast(int, x), 15)), r1 = __builtin_bit_cast(float, __builtin_amdgcn_readlane(__builtin_bit_cast(int, x), 31)),
                r2 = __builtin_bit_cast(float, __builtin_amdgcn_readlane(__builtin_bit_cast(int, x), 47)), r3 = __builtin_bit_cast(float, __builtin_amdgcn_readlane(__builtin_bit_cast(int, x), 63));
    const int row = lane >> 4; const float off = row == 0 ? 0.f : row == 1 ? r0 : row == 2 ? r0 + r1 : r0 + r1 + r2;
    tot = (r0 + r1) + (r2 + r3);
    return x + off;
}
__device__ __forceinline__ void mixC1_fast(Frame& F, kptr_t kp, int l) {
    unsigned char* ws = KWS();
    const bf16* Z = (const bf16*)(ws + WS_Z); bf16* QP = (bf16*)(ws + WS_QP); bf16* KP = (bf16*)(ws + WS_KP); bf16* ST = (bf16*)(ws + WS_ST); float* SN = (float*)(ws + WS_SN); float* GS = (float*)(ws + WS_GS);
    const float* gb = KIN(I_GATEB) + l * 24;
    constexpr int C1B = 2 * 9216 + 512;
    LAS float* cwl = (LAS float*)(F.lds + 2 * C1B); LAS float* cbl = cwl + 384;
    LAS float* cst = cbl + 128; LAS float* snt = cst + 1024;
    const int h = blockIdx.x % 6, jg = blockIdx.x / 6, nh = (F.G - h + 5) / 6;
    { const float* cw = KIN(I_CONVW) + (size_t)l * 3 * 768; const float* cb = KIN(I_CONVB) + l * 768;
        for (int i = F.tid; i < 384; i += NTHR) { const int j = i >> 7, c = i & 127; cwl[i] = cw[j * 768 + (c >> 6) * 384 + h * 64 + (c & 63)]; }
        if (F.tid < 128) cbl[F.tid] = cb[(F.tid >> 6) * 384 + h * 64 + (F.tid & 63)];
        for (int i = F.tid; i < 1024; i += NTHR) { const int pos = i >> 4, jf = i & 15; const float ang = (float)pos * exp2f(-(float)jf * 0.8304820237218406f); cst[i] = __cosf(ang); snt[i] = __sinf(ang); } }
    __syncthreads();
    const int lane = F.lane, r = lane & 15, g = lane >> 4, w = F.wave;
    const int tt = F.tid >> 3, which = (F.tid >> 2) & 1, qtr = F.tid & 3, half = qtr >> 1, j0 = (qtr & 1) * 8;
    C1Pref P;
    if (jg < 16 * 68) c1_prefetch(P, Z, gb, F.tid, jg / 68, h, jg % 68);
    int it = 0;
    for (int v = jg; v < 16 * 68; v += nh, ++it) {
        const int b = v / 68, cs = v % 68; const bool isctx = cs < 4;
        const size_t row0 = chunk_row0(b, cs); const int t = (isctx ? cs * 64 : (cs - 4) * 64) + tt;
        LAS unsigned char* KT = F.lds + (it & 1) * C1B; LAS unsigned char* VTl = KT + 9216; LAS float* aw = (LAS float*)(KT + 18432);
        C1Pref Pn = P;
        if (v + nh < 16 * 68) c1_prefetch(Pn, Z, gb, F.tid, (v + nh) / 68, h, (v + nh) % 68);
        if (F.tid < 128) { const int dir = F.tid >> 6, tq = F.tid & 63; const float Pgi = bf2f(P.gir) + P.gbi, Pgf = bf2f(P.gfr) + P.gbf; const float xl = logsigmoidf_(Pgf); float tot;
            const float pin = wave_incl_scan(xl, tq, tot); const float x = dir == 0 ? pin : tot - pin + xl;
            aw[F.tid] = __expf(tot - x + Pgi);
            { const size_t gidx = ((size_t)((b * 6 + h) * 2 + dir) * 68 + cs) * 64 + tq; ((float*)(ws + WS_CUMG))[gidx] = x; ((float*)(ws + WS_LIGG))[gidx] = Pgi; }
            if (tq == 0) GS[(size_t)((b * 6 + h) * 2 + dir) * 68 + cs] = __expf(tot); }
        {
            float va[8], vb[8];
            const int cidx = which * 64 + half * 32 + j0;
#pragma unroll
            for (int i = 0; i < 8; ++i) { va[i] = cbl[cidx + i]; vb[i] = cbl[cidx + 16 + i]; }
#pragma unroll
            for (int j = 0; j < 3; ++j) { float x[8], y[8]; const v4u zz = {0u, 0u, 0u, 0u}; const bool okj = (P.okm >> j) & 1; unpack8(okj ? P.z[2 * j] : zz, x); unpack8(okj ? P.z[2 * j + 1] : zz, y);
#pragma unroll
                for (int i = 0; i < 8; ++i) { va[i] += cwl[j * 128 + cidx + i] * x[i]; vb[i] += cwl[j * 128 + cidx + 16 + i] * y[i]; } }
#pragma unroll
            for (int i = 0; i < 8; ++i) { va[i] = siluf_(va[i]); vb[i] = siluf_(vb[i]); }
            if (!isctx) { const int pos = half ? (t & 63) : (t >> 6);
#pragma unroll
                for (int i = 0; i < 8; ++i) { const float c = cst[pos * 16 + j0 + i], s = snt[pos * 16 + j0 + i], x1 = va[i], x2 = vb[i]; va[i] = x1 * c - x2 * s; vb[i] = x1 * s + x2 * c; } }
            if (which) {
#pragma unroll
                for (int i = 0; i < 8; ++i) { va[i] *= 0.125f; vb[i] *= 0.125f; }
            }
            bf16* op = (which ? KP : QP) + ((size_t)h * MROWS + row0 + tt) * 64 + half * 32 + j0;
            v4u oa, ob; oa.x = pk2(va[0], va[1]); oa.y = pk2(va[2], va[3]); oa.z = pk2(va[4], va[5]); oa.w = pk2(va[6], va[7]); ob.x = pk2(vb[0], vb[1]); ob.y = pk2(vb[2], vb[3]); ob.z = pk2(vb[4], vb[5]); ob.w = pk2(vb[6], vb[7]);
            *(v4u*)op = oa; *(v4u*)(op + 16) = ob;
            if (which) { const int co = tt * TS64 + (half * 32 + j0) * 2; *(LAS v4u*)(KT + co) = oa; *(LAS v4u*)(KT + co + 32) = ob; }
            *(LAS v4u*)(VTl + (F.tid >> 3) * TS64 + (F.tid & 7) * 16) = P.v;
        }
        __syncthreads();
        {
            const int dir = w >> 2, mk = w & 3; LAS const float* awd = aw + dir * 64;
            const mbf16x8 a0 = scale_frag(trfrag(KT, 0, 16 * mk, lane), awd, 0, g), a1 = scale_frag(trfrag(KT, 32, 16 * mk, lane), awd, 32, g);
            bf16* stp = ST + ((size_t)((b * 6 + h) * 2 + dir) * 68 + cs) * 4096 + 16 * mk + 4 * g;
            { const v4u onesu = {0x3F803F80u, 0x3F803F80u, 0x3F803F80u, 0x3F803F80u}; const mbf16x8 ones = __builtin_bit_cast(mbf16x8, onesu); f32x4 sn = {0.f, 0.f, 0.f, 0.f};
                sn = __builtin_amdgcn_mfma_f32_16x16x32_bf16(a0, ones, sn, 0, 0, 0); sn = __builtin_amdgcn_mfma_f32_16x16x32_bf16(a1, ones, sn, 0, 0, 0);
                if (r == 0) *(f32x4*)(SN + ((size_t)((b * 6 + h) * 2 + dir) * 68 + cs) * 64 + 16 * mk + 4 * g) = sn; }
#pragma unroll
            for (int nd = 0; nd < 4; ++nd) { f32x4 acc = {0.f, 0.f, 0.f, 0.f};
                acc = __builtin_amdgcn_mfma_f32_16x16x32_bf16(a0, trfrag(VTl, 0, 16 * nd, lane), acc, 0, 0, 0);
                acc = __builtin_amdgcn_mfma_f32_16x16x32_bf16(a1, trfrag(VTl, 32, 16 * nd, lane), acc, 0, 0, 0);
                *(unsigned long long*)(stp + (16 * nd + r) * 64) = (unsigned long long)pk2(acc[0], acc[1]) | ((unsigned long long)pk2(acc[2], acc[3]) << 32); } }
        P = Pn;
    }
}

__device__ __forceinline__ int scan_slot(int dir, int i) { return dir == 0 ? i : (i < 4 ? 3 - i : 71 - i); }
__device__ __forceinline__ void mixC2_fast(Frame& F, kptr_t kp) {
    unsigned char* ws = KWS();
    bf16* ST = (bf16*)(ws + WS_ST); float* SN = (float*)(ws + WS_SN); const float* GS = (const float*)(ws + WS_GS);
    for (int gid = blockIdx.x * NTHR + F.tid; gid < 192 * 512 + 192 * 64; gid += F.G * NTHR) {
        if (gid < 192 * 512) {
            const int chain = gid >> 9, grp = gid & 511, dir = chain & 1;
            bf16* base = ST + (size_t)chain * 68 * 4096 + grp * 8; const float* gsc = GS + chain * 68;
            float s[8]; float zero_ = 0.f; asm volatile("" : "+v"(zero_));
#pragma unroll
            for (int j = 0; j < 8; ++j) s[j] = zero_;
#define C2_BATCH(I0, NB_) do { v4u d[NB_]; float gg[NB_]; \
                _Pragma("unroll") for (int k = 0; k < NB_; ++k) { const int sl = scan_slot(dir, (I0) + k); d[k] = *(const v4u*)(base + (size_t)sl * 4096); gg[k] = gsc[sl]; } \
                _Pragma("unroll") for (int k = 0; k < NB_; ++k) { const int sl = scan_slot(dir, (I0) + k); float x[8]; unpack8(d[k], x); \
                    v4u o; o.x = pk2(s[0], s[1]); o.y = pk2(s[2], s[3]); o.z = pk2(s[4], s[5]); o.w = pk2(s[6], s[7]); \
                    *(v4u*)(base + (size_t)sl * 4096) = o; \
                    _Pragma("unroll") for (int j = 0; j < 8; ++j) s[j] = gg[k] * s[j] + x[j]; } } while (0)
            for (int i0 = 0; i0 < 64; i0 += 8) C2_BATCH(i0, 8);
            C2_BATCH(64, 4);
#undef C2_BATCH
        } else {
            const int e = gid - 192 * 512, chain = e >> 6, dk = e & 63, dir = chain & 1;
            float* base = SN + (size_t)chain * 68 * 64 + dk; const float* gsc = GS + chain * 68; float s = 0.f;
            for (int i0 = 0; i0 < 68; i0 += 17) { float x[17], gq[17];
#pragma unroll
                for (int k = 0; k < 17; ++k) { const int sl = scan_slot(dir, i0 + k); x[k] = base[sl * 64]; gq[k] = gsc[sl]; }
#pragma unroll
                for (int k = 0; k < 17; ++k) { const int sl = scan_slot(dir, i0 + k); base[sl * 64] = s; s = gq[k] * s + x[k]; } }
        }
    }
}

struct C3Pref { v4u q, k, v, sf, sb; float gi, gf, nv; };
__device__ __forceinline__ void c3_prefetch(C3Pref& P, const bf16* Z, const bf16* QP, const bf16* KP, const bf16* ST, const float* SN, const float* CUMp, const float* LIGp, int tid, int b, int h, int cs) {
    const size_t row0 = chunk_row0(b, cs); const int rw = tid >> 3, ch = tid & 7;
    const size_t chf = ((size_t)((b * 6 + h) * 2 + 0) * 68 + cs), chb = chf + 68;
    P.q = *(const v4u*)(QP + ((size_t)h * MROWS + row0 + rw) * 64 + ch * 8); P.k = *(const v4u*)(KP + ((size_t)h * MROWS + row0 + rw) * 64 + ch * 8);
    P.v = *(const v4u*)(zh(Z, G_CV + h, row0 + rw) + ch * 8);
    P.sf = *(const v4u*)(ST + chf * 4096 + rw * 64 + ch * 8); P.sb = *(const v4u*)(ST + chb * 4096 + rw * 64 + ch * 8);
    if (tid < 128) { const int dir = tid >> 6; const size_t gidx = (dir ? chb : chf) * 64 + (tid & 63);
        P.gi = LIGp[gidx]; P.gf = CUMp[gidx];
        P.nv = SN[gidx]; }
}
__device__ __forceinline__ void mixC3_fast(Frame& F, kptr_t kp, int l, bool ctx_out) {
    unsigned char* ws = KWS();
    const bf16* Z = (const bf16*)(ws + WS_Z); const bf16* QP = (const bf16*)(ws + WS_QP); const bf16* KP = (const bf16*)(ws + WS_KP); const bf16* ST = (const bf16*)(ws + WS_ST);
    const float* SN = (const float*)(ws + WS_SN); bf16* Y = (bf16*)(ws + WS_RB);
    const float* CUMp = (const float*)(ws + WS_CUMG); const float* LIGp = (const float*)(ws + WS_LIGG);
    LAS unsigned char* QT = F.lds; LAS unsigned char* KT = F.lds + 9216; LAS unsigned char* VTl = F.lds + 2 * 9216; LAS unsigned char* SF = F.lds + 3 * 9216; LAS unsigned char* SB = F.lds + 4 * 9216;
    LAS float* cum = (LAS float*)(F.lds + 5 * 9216); LAS float* lig = cum + 128; LAS float* nv = lig + 128;
    const int lane = F.lane, r = lane & 15, g = lane >> 4, w = F.wave;
    const int nper = ctx_out ? 68 : 64, nunit = NB * 6 * nper;
    C3Pref P;
#define C3_UNIT(u_, b_, h_, cs_) const int b_ = (u_) / (6 * nper), h_ = ((u_) / nper) % 6, cs_ = ((u_) % nper) + (68 - nper)
    if ((int)blockIdx.x < nunit) { C3_UNIT(blockIdx.x, b0, h0, cs0); c3_prefetch(P, Z, QP, KP, ST, SN, CUMp, LIGp, F.tid, b0, h0, cs0); }
    for (int u = blockIdx.x; u < nunit; u += F.G) {
        C3_UNIT(u, b, h, cs);
        const size_t row0 = chunk_row0(b, cs);
        { const int rw = F.tid >> 3, ch = F.tid & 7, o = rw * TS64 + ch * 16;
            *(LAS v4u*)(QT + o) = P.q; *(LAS v4u*)(KT + o) = P.k; *(LAS v4u*)(VTl + o) = P.v; *(LAS v4u*)(SF + o) = P.sf; *(LAS v4u*)(SB + o) = P.sb; }
        if (F.tid < 128) { const float x = P.gf;
            cum[F.tid] = x; lig[F.tid] = P.gi; nv[F.tid] = P.nv; }
        __syncthreads();
        if (u + F.G < nunit) { C3_UNIT(u + F.G, b1, h1, cs1); c3_prefetch(P, Z, QP, KP, ST, SN, CUMp, LIGp, F.tid, b1, h1, cs1); }
        const int nt = w >> 1, dvh = w & 1, t = 16 * nt + r;
        const bf16* cop = zh(Z, G_CO + h, row0 + t) + 32 * dvh + 4 * g;
        const unsigned long long co0 = *(const unsigned long long*)cop, co1 = *(const unsigned long long*)(cop + 16);
        const mbf16x8 qf0 = *(LAS const mbf16x8*)(QT + t * TS64 + g * 16), qf1 = *(LAS const mbf16x8*)(QT + t * TS64 + g * 16 + 64);
        f32x4 st[4];
#pragma unroll
        for (int mt = 0; mt < 4; ++mt) { LAS const unsigned char* ka = KT + (16 * mt + r) * TS64 + g * 16; f32x4 z0 = {0.f, 0.f, 0.f, 0.f};
            z0 = __builtin_amdgcn_mfma_f32_16x16x32_bf16(*(LAS const mbf16x8*)ka, qf0, z0, 0, 0, 0); st[mt] = __builtin_amdgcn_mfma_f32_16x16x32_bf16(*(LAS const mbf16x8*)(ka + 64), qf1, z0, 0, 0, 0); }
        const float cft = cum[t], cbt = cum[64 + t], wf = __expf(cft), wb = __expf(cbt);
        float pf[16], pb[16], dnf = 0.f, dnb = 0.f;
#pragma unroll
        for (int mt = 0; mt < 4; ++mt) { const int s0 = 16 * mt + 4 * g;
            const f32x4 cfs = *(LAS const f32x4*)(cum + s0), cbs = *(LAS const f32x4*)(cum + 64 + s0), lfs = *(LAS const f32x4*)(lig + s0), lbs = *(LAS const f32x4*)(lig + 64 + s0);
#pragma unroll
            for (int rg = 0; rg < 4; ++rg) { const int sx = s0 + rg;
                const float a = (sx <= t) ? st[mt][rg] * __expf(cft - cfs[rg] + lfs[rg]) : 0.f, c = (sx >= t) ? st[mt][rg] * __expf(cbt - cbs[rg] + lbs[rg]) : 0.f;
                pf[mt * 4 + rg] = a; pb[mt * 4 + rg] = c; dnf += a; dnb += c; } }
        {
            float x[8], y[8]; unpack8(__builtin_bit_cast(v4u, qf0), x); unpack8(__builtin_bit_cast(v4u, qf1), y); float qf_ = 0.f, qb_ = 0.f;
#pragma unroll
            for (int j = 0; j < 8; ++j) { qf_ += x[j] * nv[8 * g + j] + y[j] * nv[32 + 8 * g + j]; qb_ += x[j] * nv[64 + 8 * g + j] + y[j] * nv[96 + 8 * g + j]; }
            dnf += wf * qf_; dnb += wb * qb_; }
        dnf += __shfl_xor(dnf, 16); dnf += __shfl_xor(dnf, 32); dnb += __shfl_xor(dnb, 16); dnb += __shfl_xor(dnb, 32);
        const float rdf = __builtin_amdgcn_rcpf(fmaxf(fabsf(dnf), 1.f)), rdb = __builtin_amdgcn_rcpf(fmaxf(fabsf(dnb), 1.f));
        mbf16x8 pff[2], pbf[2];
#pragma unroll
        for (int ks = 0; ks < 2; ++ks) { v4u a, c;
            a.x = pk2(pf[ks * 8 + 0], pf[ks * 8 + 1]); a.y = pk2(pf[ks * 8 + 2], pf[ks * 8 + 3]); a.z = pk2(pf[ks * 8 + 4], pf[ks * 8 + 5]); a.w = pk2(pf[ks * 8 + 6], pf[ks * 8 + 7]);
            c.x = pk2(pb[ks * 8 + 0], pb[ks * 8 + 1]); c.y = pk2(pb[ks * 8 + 2], pb[ks * 8 + 3]); c.z = pk2(pb[ks * 8 + 4], pb[ks * 8 + 5]); c.w = pk2(pb[ks * 8 + 6], pb[ks * 8 + 7]);
            pff[ks] = __builtin_bit_cast(mbf16x8, a); pbf[ks] = __builtin_bit_cast(mbf16x8, c); }
        bf16* yp = Y + pg8::tiled_off(row0 + t, Y_C + h * 64 + 32 * dvh + 4 * g, DM);
#pragma unroll
        for (int mi = 0; mi < 2; ++mi) { const int md = 2 * dvh + mi;
            const mbf16x8 v0 = trfrag(VTl, 0, 16 * md, lane), v1 = trfrag(VTl, 32, 16 * md, lane);
            f32x4 z0 = {0.f, 0.f, 0.f, 0.f};
            f32x4 inf_ = __builtin_amdgcn_mfma_f32_16x16x32_bf16(v0, pff[0], z0, 0, 0, 0); inf_ = __builtin_amdgcn_mfma_f32_16x16x32_bf16(v1, pff[1], inf_, 0, 0, 0);
            f32x4 inb_ = __builtin_amdgcn_mfma_f32_16x16x32_bf16(v0, pbf[0], z0, 0, 0, 0); inb_ = __builtin_amdgcn_mfma_f32_16x16x32_bf16(v1, pbf[1], inb_, 0, 0, 0);
            LAS const unsigned char* sfa = SF + (16 * md + r) * TS64 + g * 16; LAS const unsigned char* sba = SB + (16 * md + r) * TS64 + g * 16;
            f32x4 itf = __builtin_amdgcn_mfma_f32_16x16x32_bf16(*(LAS const mbf16x8*)sfa, qf0, z0, 0, 0, 0); itf = __builtin_amdgcn_mfma_f32_16x16x32_bf16(*(LAS const mbf16x8*)(sfa + 64), qf1, itf, 0, 0, 0);
            f32x4 itb = __builtin_amdgcn_mfma_f32_16x16x32_bf16(*(LAS const mbf16x8*)sba, qf0, z0, 0, 0, 0); itb = __builtin_amdgcn_mfma_f32_16x16x32_bf16(*(LAS const mbf16x8*)(sba + 64), qf1, itb, 0, 0, 0);
            const unsigned long long cw_ = mi ? co1 : co0; const unsigned clo = (unsigned)cw_, chi = (unsigned)(cw_ >> 32);
            const float cg[4] = {bflo(clo), bfhi(clo), bflo(chi), bfhi(chi)}; float yv[4];
#pragma unroll
            for (int rg = 0; rg < 4; ++rg) yv[rg] = ((inf_[rg] + wf * itf[rg]) * rdf + (inb_[rg] + wb * itb[rg]) * rdb) * sigmoidf_(cg[rg]);
            *(unsigned long long*)(yp + 16 * mi) = (unsigned long long)pk2(yv[0], yv[1]) | ((unsigned long long)pk2(yv[2], yv[3]) << 32); }
        __syncthreads();
    }
#undef C3_UNIT
}

__device__ __forceinline__ void mixA_fast(Frame& F, kptr_t kp, int l, int nchunks) {
    unsigned char* ws = KWS();
    const bf16* Z = (const bf16*)(ws + WS_Z); bf16* Y = (bf16*)(ws + WS_RB);
    LAS unsigned char* WT = F.lds;
    LAS unsigned char* VTa = F.lds + 128 * TS128;
    LAS unsigned char* UT = VTa + 64 * TS128;
    const int gsel = blockIdx.x & 3, nblk = F.G >> 2;
    if ((int)(blockIdx.x >> 2) >= nchunks) return;
    { const float* wsrc = KIN(I_AWS) + (size_t)(l * 4 + gsel) * 128 * 128;
        for (int i = F.tid; i < 128 * 16; i += NTHR) { const int p = i >> 4, c8 = i & 15; const f32x4 a = *(const f32x4*)(wsrc + p * 128 + c8 * 8), b = *(const f32x4*)(wsrc + p * 128 + c8 * 8 + 4);
            v4u o; o.x = pk2(a.x, a.y); o.y = pk2(a.z, a.w); o.z = pk2(b.x, b.y); o.w = pk2(b.z, b.w); *(LAS v4u*)(WT + p * TS128 + c8 * 16) = o; } }
    const int p = F.tid >> 2, qd = F.tid & 3, lane = F.lane, r = lane & 15, g = lane >> 4, w = F.wave;
    const float* lg = KIN(I_ALNG) + (l * 4 + gsel) * 64 + qd * 16; const float* lb = KIN(I_ALNB) + (l * 4 + gsel) * 64 + qd * 16; const float* bsp = KIN(I_ABS) + (l * 4 + gsel) * 128;
    v4u nv0, nv1, nu0, nu1;
#define MIXA_LOAD(chn) do { const size_t row_ = (size_t)(chn) * 128 + p; const bf16* a_ = zh(Z, G_AV + gsel, row_) + qd * 16; const bf16* b_ = zh(Z, G_AU + gsel, row_) + qd * 16; \
        nv0 = *(const v4u*)a_; nv1 = *(const v4u*)(a_ + 8); nu0 = *(const v4u*)b_; nu1 = *(const v4u*)(b_ + 8); } while (0)
#define MIXA_UN16(a_, b_, v_) do { v_[0] = bflo(a_.x); v_[1] = bfhi(a_.x); v_[2] = bflo(a_.y); v_[3] = bfhi(a_.y); v_[4] = bflo(a_.z); v_[5] = bfhi(a_.z); v_[6] = bflo(a_.w); v_[7] = bfhi(a_.w); \
        v_[8] = bflo(b_.x); v_[9] = bfhi(b_.x); v_[10] = bflo(b_.y); v_[11] = bfhi(b_.y); v_[12] = bflo(b_.z); v_[13] = bfhi(b_.z); v_[14] = bflo(b_.w); v_[15] = bfhi(b_.w); } while (0)
    MIXA_LOAD(blockIdx.x >> 2);
    for (int ch = blockIdx.x >> 2; ch < nchunks; ch += nblk) {
        const v4u cv0 = nv0, cv1 = nv1, cu0 = nu0, cu1 = nu1;
        if (ch + nblk < nchunks) MIXA_LOAD(ch + nblk);
        { float v[16]; MIXA_UN16(cv0, cv1, v);
            float s = 0.f;
#pragma unroll
            for (int i = 0; i < 16; ++i) { v[i] = gelu_tanh(v[i]); s += v[i]; }
            s += __shfl_xor(s, 1); s += __shfl_xor(s, 2);
            const float mu = s * (1.f / 64.f); float s2 = 0.f;
#pragma unroll
            for (int i = 0; i < 16; ++i) { v[i] -= mu; s2 += v[i] * v[i]; }
            s2 += __shfl_xor(s2, 1); s2 += __shfl_xor(s2, 2);
            const float rstd = __builtin_amdgcn_rsqf(s2 * (1.f / 64.f) + EPS);
#pragma unroll
            for (int i = 0; i < 16; ++i) *(LAS unsigned short*)(VTa + (qd * 16 + i) * TS128 + p * 2) = f2bfs(v[i] * rstd * lg[i] + lb[i]);
            float uu[16]; MIXA_UN16(cu0, cu1, uu);
            v4u a, b; a.x = pk2(gelu_tanh(uu[0]), gelu_tanh(uu[1])); a.y = pk2(gelu_tanh(uu[2]), gelu_tanh(uu[3])); a.z = pk2(gelu_tanh(uu[4]), gelu_tanh(uu[5])); a.w = pk2(gelu_tanh(uu[6]), gelu_tanh(uu[7]));
            b.x = pk2(gelu_tanh(uu[8]), gelu_tanh(uu[9])); b.y = pk2(gelu_tanh(uu[10]), gelu_tanh(uu[11])); b.z = pk2(gelu_tanh(uu[12]), gelu_tanh(uu[13])); b.w = pk2(gelu_tanh(uu[14]), gelu_tanh(uu[15]));
            *(LAS v4u*)(UT + p * TS64 + qd * 32) = a; *(LAS v4u*)(UT + p * TS64 + qd * 32 + 16) = b; }
        __syncthreads();
        { LAS const unsigned char* ap = WT + (16 * w + r) * TS128 + g * 16;
#pragma unroll
            for (int nt = 0; nt < 4; ++nt) { f32x4 acc = {0.f, 0.f, 0.f, 0.f}; acc = mma16<4>(ap, VTa + (16 * nt + r) * TS128 + g * 16, acc);
#pragma unroll
                for (int rg = 0; rg < 4; ++rg) { const int pp = 16 * w + 4 * g + rg; LAS unsigned short* up = (LAS unsigned short*)(UT + pp * TS64 + (16 * nt + r) * 2);
                    *up = f2bfs(bf2f(*up) * (acc[rg] + bsp[pp])); } } }
        __syncthreads();
#pragma unroll
        for (int i = 0; i < 2; ++i) { const int idx = F.tid + i * NTHR, rw = idx >> 3, c8 = idx & 7; *(v4u*)(Y + pg8::tiled_off((size_t)ch * 128 + rw, Y_A + gsel * 64 + c8 * 8, DM)) = *(LAS const v4u*)(UT + rw * TS64 + c8 * 16); }
        __syncthreads();
    }
#undef MIXA_LOAD
#undef MIXA_UN16
}

struct BSt { float m, l; bool fresh; f32x4 ot[4]; };
constexpr float B_SC2 = 0.125f * 1.4426950408889634f;
__device__ __forceinline__ void b_update(BSt& st, float (&v)[16], int n, const mbf16x8* vfr  ) {
    float tmax = v[0];
#pragma unroll
    for (int i = 1; i < 16; ++i) if (i < n) tmax = fmaxf(tmax, v[i]);
    tmax = fmaxf(tmax, __shfl_xor(tmax, 16)); tmax = fmaxf(tmax, __shfl_xor(tmax, 32));
    if (__builtin_expect(st.fresh || __any(tmax > 6.f), 0)) { const float d = st.fresh ? tmax : fmaxf(tmax, 0.f), al = __builtin_amdgcn_exp2f(-d); st.m += d; st.l *= al; st.fresh = false;
#pragma unroll
        for (int md = 0; md < 4; ++md) st.ot[md] = st.ot[md] * al;
#pragma unroll
        for (int i = 0; i < 16; ++i) if (i < n) v[i] -= d; }
    float sum = 0.f;
#pragma unroll
    for (int i = 0; i < 16; ++i) if (i < n) { v[i] = __builtin_amdgcn_exp2f(v[i]); sum += v[i]; }
    st.l += sum;
#pragma unroll
    for (int ks = 0; ks < 2; ++ks) if (ks * 8 < n) {
        v4u pk; pk.x = pk2(v[ks * 8 + 0], v[ks * 8 + 1]); pk.y = pk2(v[ks * 8 + 2], v[ks * 8 + 3]); pk.z = pk2(v[ks * 8 + 4], v[ks * 8 + 5]); pk.w = pk2(v[ks * 8 + 6], v[ks * 8 + 7]);
        const mbf16x8 pb = __builtin_bit_cast(mbf16x8, pk);
#pragma unroll
        for (int md = 0; md < 4; ++md) st.ot[md] = __builtin_amdgcn_mfma_f32_16x16x32_bf16(vfr[ks * 4 + md], pb, st.ot[md], 0, 0, 0); }
}
template <int NG>
__device__ __forceinline__ void mixB_fast(Frame& F, kptr_t kp, int l, bool ctx_out) {
    unsigned char* ws = KWS();
    const bf16* Z = (const bf16*)(ws + WS_Z); bf16* Y = (bf16*)(ws + WS_RB);
    LAS unsigned char* KB0 = F.lds; LAS unsigned char* VB0 = F.lds + 9216;
    LAS float* rpbs = (LAS float*)(F.lds + 2 * 18432);
    const int lane = F.lane, r = lane & 15, g = lane >> 4, w = F.wave;
    constexpr int UR = 2 * NG, NJ = 64 / UR;
    const int nlat = NB * 6 * NJ, nctx = ctx_out ? NB * 6 : 0;
    const int ldrow = F.tid >> 3, ldch = F.tid & 7;
    v4u kreg, vreg; float rp0 = 0.f, rp1 = 0.f;
#define MIXB_COORD(uu, latv, bv, hv, jrv) do { latv = (uu) < nlat; jrv = 0; if (latv) { bv = (uu) / (6 * NJ); hv = ((uu) / NJ) % 6; jrv = (uu) % NJ; } else { const int v_ = (uu) - nlat; bv = v_ / 6; hv = v_ % 6; } } while (0)
#define MIXB_PREF(latv, bv, hv, jrv) do { const int kmin_ = min(max(UR * (jrv) - 4, 0), 56); \
        const size_t trow_ = (latv) ? (size_t)(bv) * SEQ + kmin_ * 64 + ldrow : (size_t)NLAT + (bv) * CTXL + ldrow; \
        kreg = *(const v4u*)(zh(Z, G_BK + (hv), trow_) + ldch * 8); vreg = *(const v4u*)(zh(Z, G_BV + (hv), trow_) + ldch * 8); \
        if (latv) { const float* rp_ = KIN(I_RPB) + (size_t)(l * 6 + (hv)) * 465; const int i0_ = F.tid, i1_ = F.tid + NTHR; \
            const int dc0_ = (i0_ & 63) - 31, dc1_ = (i1_ & 63) - 31; \
            rp0 = (dc0_ >= -15 && dc0_ <= 15) ? 1.4426950408889634f * rp_[(i0_ >> 6) * 31 + dc0_ + 15] : -1e30f; \
            rp1 = (i1_ < 15 * 64 && dc1_ >= -15 && dc1_ <= 15) ? 1.4426950408889634f * rp_[(i1_ >> 6) * 31 + dc1_ + 15] : -1e30f; } } while (0)
    { const int u0 = blockIdx.x; if (u0 < nlat + nctx) { bool lat0; int b0, h0, jr0; MIXB_COORD(u0, lat0, b0, h0, jr0); MIXB_PREF(lat0, b0, h0, jr0); } }
    for (int u = blockIdx.x; u < nlat + nctx; u += F.G) {
        bool lat; int b, h, jr;
        MIXB_COORD(u, lat, b, h, jr);
        const int ngact = lat ? NG : 2;
        const int rrh = w >> 2, cg = w & 3, qr0 = UR * jr + NG * rrh, c0 = 16 * cg, c = c0 + r;
        const size_t qrow0 = lat ? (size_t)b * SEQ + qr0 * 64 + c : (size_t)NLAT + b * CTXL + 32 * w + r;
        const int qstride = lat ? 64 : 16;
        const int kc_lo = (cg == 0) ? 0 : (cg == 1) ? 8 : (cg == 2) ? 24 : 32, kcq = min(max(c - 8, 0), 48);
        const int kmin = min(max(UR * jr - 4, 0), 56), kmax = min(max(UR * jr + UR - 1 - 4, 0), 56) + 7;
        const int nwin = lat ? (kmax - kmin + 1) : 0, ntile = nwin + 4;
        mbf16x8 qf[NG][2];
#pragma unroll
        for (int gi = 0; gi < NG; ++gi) { const bf16* qp = zh(Z, G_BQ + h, qrow0 + (size_t)(gi < ngact ? gi : 0) * qstride) + g * 8;
#pragma unroll
            for (int k2 = 0; k2 < 2; ++k2) { float x[8]; unpack8(*(const v4u*)(qp + 32 * k2), x); v4u o; o.x = pk2(x[0] * B_SC2, x[1] * B_SC2); o.y = pk2(x[2] * B_SC2, x[3] * B_SC2); o.z = pk2(x[4] * B_SC2, x[5] * B_SC2); o.w = pk2(x[6] * B_SC2, x[7] * B_SC2);
                qf[gi][k2] = __builtin_bit_cast(mbf16x8, o); } }
        int idx[8];
#pragma unroll
        for (int i = 0; i < 8; ++i) { const int kc = kc_lo + 16 * (i >> 2) + 4 * g + (i & 3); idx[i] = (kc >= kcq && kc < kcq + 16) ? (kc - c + 31) : 63; }
        if (lat) { rpbs[F.tid] = rp0; if (F.tid + NTHR < 15 * 64) rpbs[F.tid + NTHR] = rp1; }
#define MIXB_LOAD(ti) do { const size_t trow = ((ti) < nwin) ? (size_t)b * SEQ + (kmin + (ti)) * 64 + ldrow : (size_t)NLAT + b * CTXL + ((ti) - nwin) * 64 + ldrow; \
        kreg = *(const v4u*)(zh(Z, G_BK + h, trow) + ldch * 8); vreg = *(const v4u*)(zh(Z, G_BV + h, trow) + ldch * 8); } while (0)
#define MIXB_STORE(bufi) do { *(LAS v4u*)(KB0 + (bufi) * 18432 + ldrow * TS64 + ldch * 16) = kreg; *(LAS v4u*)(VB0 + (bufi) * 18432 + ldrow * TS64 + ldch * 16) = vreg; } while (0)
        MIXB_STORE(0);
        __syncthreads();
        BSt st[NG];
#pragma unroll
        for (int gi = 0; gi < NG; ++gi) { st[gi].m = 0.f; st[gi].l = 0.f; st[gi].fresh = true;
#pragma unroll
            for (int md = 0; md < 4; ++md) st[gi].ot[md] = (f32x4){0.f, 0.f, 0.f, 0.f}; }
        for (int ti = 0; ti < ntile; ++ti) {
            const int buf = ti & 1;
            if (ti + 1 < ntile) MIXB_LOAD(ti + 1);
            else if (u + F.G < nlat + nctx) { bool latn; int bn, hn, jrn; MIXB_COORD(u + F.G, latn, bn, hn, jrn); MIXB_PREF(latn, bn, hn, jrn); }
            LAS const unsigned char* kb = KB0 + buf * 18432; LAS const unsigned char* vb = VB0 + buf * 18432;
            if (ti < nwin) {
                const int kr = kmin + ti;
                const int klo = min(max(qr0 - 4, 0), 56), khi = min(max(qr0 + NG - 1 - 4, 0), 56) + 7;
                if (kr >= klo && kr <= khi) {
                    mbf16x8 kf[2][2], vfr[4];
#pragma unroll
                    for (int mt = 0; mt < 2; ++mt) { LAS const unsigned char* ka = kb + (kc_lo + 16 * mt + r) * TS64 + g * 16; kf[mt][0] = *(LAS const mbf16x8*)ka; kf[mt][1] = *(LAS const mbf16x8*)(ka + 64); }
#pragma unroll
                    for (int md = 0; md < 4; ++md) vfr[md] = trfrag(vb, kc_lo, 16 * md, lane);
#pragma unroll
                    for (int gi = 0; gi < NG; ++gi) { const int qr = qr0 + gi, k0 = min(max(qr - 4, 0), 56);
                        if (kr >= k0 && kr < k0 + 8) { float v[16]; LAS const float* rowp = rpbs + (kr - qr + 7) * 64;
#pragma unroll
                            for (int mt = 0; mt < 2; ++mt) { const float nm = -st[gi].m; f32x4 z0 = {nm, nm, nm, nm}; z0 = __builtin_amdgcn_mfma_f32_16x16x32_bf16(kf[mt][0], qf[gi][0], z0, 0, 0, 0); z0 = __builtin_amdgcn_mfma_f32_16x16x32_bf16(kf[mt][1], qf[gi][1], z0, 0, 0, 0);
#pragma unroll
                                for (int rg = 0; rg < 4; ++rg) v[mt * 4 + rg] = z0[rg] + rowp[idx[mt * 4 + rg]]; }
                            b_update(st[gi], v, 8, vfr); } }
                }
            } else {
                mbf16x8 kf[4][2], vfr[8];
#pragma unroll
                for (int mt = 0; mt < 4; ++mt) { LAS const unsigned char* ka = kb + (16 * mt + r) * TS64 + g * 16; kf[mt][0] = *(LAS const mbf16x8*)ka; kf[mt][1] = *(LAS const mbf16x8*)(ka + 64); }
#pragma unroll
                for (int ks = 0; ks < 2; ++ks)
#pragma unroll
                    for (int md = 0; md < 4; ++md) vfr[ks * 4 + md] = trfrag(vb, 32 * ks, 16 * md, lane);
#pragma unroll
                for (int gi = 0; gi < NG; ++gi) if (gi < ngact) { float v[16];
#pragma unroll
                    for (int mt = 0; mt < 4; ++mt) { const float nm = -st[gi].m; f32x4 z0 = {nm, nm, nm, nm}; z0 = __builtin_amdgcn_mfma_f32_16x16x32_bf16(kf[mt][0], qf[gi][0], z0, 0, 0, 0); z0 = __builtin_amdgcn_mfma_f32_16x16x32_bf16(kf[mt][1], qf[gi][1], z0, 0, 0, 0);
#pragma unroll
                        for (int rg = 0; rg < 4; ++rg) v[mt * 4 + rg] = z0[rg]; }
                    b_update(st[gi], v, 16, vfr); }
            }
            if (ti + 1 < ntile) MIXB_STORE(buf ^ 1);
            __syncthreads();
        }
#undef MIXB_LOAD
#undef MIXB_STORE
#pragma unroll
        for (int gi = 0; gi < NG; ++gi) if (gi < ngact) { float ls = st[gi].l; ls += __shfl_xor(ls, 16); ls += __shfl_xor(ls, 32); const float inv = __builtin_amdgcn_rcpf(ls);
            bf16* yp = Y + pg8::tiled_off(qrow0 + (size_t)gi * qstride, Y_B + h * 64 + 4 * g, DM);
#pragma unroll
            for (int md = 0; md < 4; ++md) *(unsigned long long*)(yp + 16 * md) = (unsigned long long)pk2(st[gi].ot[md][0] * inv, st[gi].ot[md][1] * inv) | ((unsigned long long)pk2(st[gi].ot[md][2] * inv, st[gi].ot[md][3] * inv) << 32); }
    }
#undef MIXB_COORD
#undef MIXB_PREF
}
#ifndef MIXB_NG
#define MIXB_NG 2
#endif
#ifndef MIXA_FAST
#define MIXA_FAST 1
#endif
#ifndef MIXB_FAST
#define MIXB_FAST 1
#endif
#ifndef MIXC_FAST
#define MIXC_FAST 1
#endif
#define PH_LO() (*(const int __attribute__((address_space(4)))*)(kp + 8 * 24))
#define PH_HI() (*(const int __attribute__((address_space(4)))*)(kp + 8 * 24 + 4))
__device__ __forceinline__ void frame_init(Frame& F, LAS unsigned char* lds) {
    int tid_l = threadIdx.x; asm volatile("" : "+v"(tid_l));
    F.lds = lds; F.tid = tid_l; F.lane = F.tid & 63; F.wave = __builtin_amdgcn_readfirstlane(F.tid >> 6);
    F.G = gridDim.x; F.gw = blockIdx.x * NWAVES + F.wave; F.NGW = F.G * NWAVES;
}
__global__ void __launch_bounds__(NTHR, 2) fwd_kernel(Args a_unused) {
    extern __shared__ __attribute__((aligned(16))) unsigned char lds_raw[];
    LAS unsigned char* const lds = (LAS unsigned char*)lds_raw;
    volatile LAS unsigned* MISC = (volatile LAS unsigned*)(lds + MISC_OFF);
    for (int u = threadIdx.x; u < (LDS_BYTES - LDSCTL_OFF) / 4; u += NTHR) ((LAS unsigned*)(lds + LDSCTL_OFF))[u] = 0u;
    __syncthreads();
    int lo, hi; XcdBarrier bar;
    { kptr_t kp = kargs(); lo = PH_LO(); hi = PH_HI(); unsigned* barw = (unsigned*)(KWS() + WS_CTL) + CW_BAR;
      bar.bar = barw; bar.x = 0; bar.st = nullptr;
      if (hi - lo > 1) bar = xcd_barrier_post(barw, MISC + 8); }
#define IN(k) (lo <= (k) && (k) < hi)
#define SEAM(k) do { if (IN(k) && IN((k) + 1)) xcd_barrier(bar); } while (0)

    if (IN(0)) { kptr_t kp = kargs(); Frame F; frame_init(F, lds); p0_prologue(F, kp); SEAM(0); }
    if (IN(1)) { kptr_t kp = kargs(); Frame F; frame_init(F, lds); p1_phase(F, kp); SEAM(1); }

    for (int l = 0; l < 2; ++l) {
        const int pb = 2 + 7 * l;
        if (IN(pb + 0)) { kptr_t kp = kargs(); unsigned char* ws = KWS();
            pg8::Gemm g{(const bf16*)(ws + WS_XN), (const bf16*)(ws + WS_WIN + l * WIN_BYTES), MROWS, ZW, DM}; pg8::PrefOrder S; S.init(MROWS, ZW, (int)gridDim.x, (int)blockIdx.x);
            S.rv = (const float*)(ws + WS_RSQ) + (size_t)(2 * l) * MROWS; S.cv = (const float*)(ws + WS_CV1) + (size_t)l * 17 * 3328; S.cvn = 3328; S.pre = lds + PRE_OFF;
            pg8::EpiZH E{(bf16*)(ws + WS_Z), MROWS, lds + PRE_OFF};
            pg8::gemm_phase<pg8::EpiZH, pg8::PrefOrder, true, true>(lds, g, S, E);
            SEAM(pb + 0);
        }
        if (IN(pb + 1)) { kptr_t kp = kargs(); Frame F; frame_init(F, lds);
            const bool ctx_out = (l == 0); const int mrows = ctx_out ? MROWS : NLAT;
            mixC1_fast(F, kp, l);
            __syncthreads();
            mixA_fast(F, kp, l, mrows / 128);
            __syncthreads();
            mixB_fast<MIXB_NG>(F, kp, l, ctx_out);
            SEAM(pb + 1);
        }
        if (IN(pb + 2)) { kptr_t kp = kargs(); Frame F; frame_init(F, lds); mixC2_fast(F, kp); SEAM(pb + 2); }
        if (IN(pb + 3)) { kptr_t kp = kargs(); Frame F; frame_init(F, lds); mixC3_fast(F, kp, l, l == 0); SEAM(pb + 3); }
        if (IN(pb + 4)) { kptr_t kp = kargs(); unsigned char* ws = KWS();
            const int mrows = NLAT; const float* modl = (const float*)(ws + WS_MOD) + (size_t)l * 17 * 6144;
            pg8::Gemm g{(const bf16*)(ws + WS_RB), (const bf16*)(ws + WS_WOUT + l * WOUT_BYTES), mrows, DM, DM}; pg8::StaticOrder S; S.init(mrows, DM, (int)gridDim.x, (int)blockIdx.x);
            pg8::EpiRes E{(const bf16*)(ws + WS_XN), KIN(I_N1G) + l * DM, modl + 1 * 1024,
                          (bf16*)(ws + WS_A2), KIN(I_N2G) + l * DM, modl + 4 * 1024, (bf16*)nullptr, (float*)(ws + WS_RSQ) + (size_t)(2 * l + 1) * MROWS, modl + 2 * 1024};
            pg8::gemm_phase<pg8::EpiRes, pg8::StaticOrder, true, true>(lds, g, S, E);
            if (l != 0) SEAM(pb + 4);
        }
        if (IN(pb + 4) && l == 0) { kptr_t kp = kargs(); unsigned char* ws = KWS(); int tid_l = threadIdx.x; asm volatile("" : "+v"(tid_l));
            const float* modc = (const float*)(ws + WS_MOD) + (size_t)16 * 6144;
            const SmallRes R{(const bf16*)(ws + WS_XN), KIN(I_N1G), modc + 1 * 1024, (bf16*)(ws + WS_A2), KIN(I_N2G), modc + 4 * 1024, (float*)(ws + WS_RSQ) + (size_t)1 * MROWS, modc + 2 * 1024};
            __syncthreads();
            ctx_small_gemm(lds, tid_l, (const bf16*)(ws + WS_RB), (const bf16*)(ws + WS_WOUT), DM, R);
            SEAM(pb + 4);
        }
        if (IN(pb + 5)) { kptr_t kp = kargs(); unsigned char* ws = KWS();
            const int mrows = (l == 0) ? MROWS : NLAT;
            pg8::Gemm g{(const bf16*)(ws + WS_A2), (const bf16*)(ws + WS_WGU + l * WGU_BYTES), mrows, 2 * DFF, DM}; pg8::PrefOrder S; S.init(mrows, 2 * DFF, (int)gridDim.x, (int)blockIdx.x);
            S.rv = (const float*)(ws + WS_RSQ) + (size_t)(2 * l + 1) * MROWS; S.cv = (const float*)(ws + WS_CV2) + (size_t)l * 17 * 5632; S.cvn = 5632; S.pre = lds + PRE_OFF;
            pg8::EpiSwiGLU E{(bf16*)(ws + WS_Z), lds + PRE_OFF};
            pg8::gemm_phase<pg8::EpiSwiGLU, pg8::PrefOrder, true, true>(lds, g, S, E);
            SEAM(pb + 5);
        }
        if (IN(pb + 6)) { kptr_t kp = kargs(); unsigned char* ws = KWS();
            const int mrows = NLAT; const float* modl = (const float*)(ws + WS_MOD) + (size_t)l * 17 * 6144;
            pg8::Gemm g{(const bf16*)(ws + WS_Z), (const bf16*)(ws + WS_WDN + l * WDN_BYTES), mrows, DM, DFF}; pg8::StaticOrder S; S.init(mrows, DM, (int)gridDim.x, (int)blockIdx.x);
            pg8::EpiRes E{(const bf16*)(ws + WS_A2), KIN(I_N2G) + l * DM, modl + 4 * 1024,
                          (bf16*)(ws + WS_XN), (l == 0) ? KIN(I_N1G) + DM : (const float*)nullptr, modl + 17 * 6144 + 1 * 1024, (bf16*)(ws + WS_RB), (float*)(ws + WS_RSQ) + (size_t)(2 * l + 2) * MROWS, modl + 5 * 1024};
            pg8::gemm_phase<pg8::EpiRes, pg8::StaticOrder, true, true>(lds, g, S, E);
            if (l != 0) SEAM(pb + 6);
        }
        if (IN(pb + 6) && l == 0) { kptr_t kp = kargs(); unsigned char* ws = KWS(); int tid_l = threadIdx.x; asm volatile("" : "+v"(tid_l));
            const float* modc = (const float*)(ws + WS_MOD) + (size_t)16 * 6144;
            const SmallRes R{(const bf16*)(ws + WS_A2), KIN(I_N2G), modc + 4 * 1024, (bf16*)(ws + WS_XN), KIN(I_N1G) + DM, modc + (size_t)17 * 6144 + 1 * 1024, (float*)(ws + WS_RSQ) + (size_t)2 * MROWS, modc + 5 * 1024};
            __syncthreads();
            ctx_small_gemm(lds, tid_l, (const bf16*)(ws + WS_Z), (const bf16*)(ws + WS_WDN), DFF, R);
            SEAM(pb + 6);
        }
    }
    if (IN(16)) { kptr_t kp = kargs(); Frame F; frame_init(F, lds); final_norm_phase(F, kp); }
#undef IN
#undef SEAM
}

#ifndef MK_ONE_LAUNCH
#define MK_ONE_LAUNCH 1
#endif
extern "C" void kernel_launch(void* const* d_in, const int* in_sizes, int n_in, void* d_out, int out_size, void* d_ws, size_t ws_size, hipStream_t stream) {
    static int grid = 0;
    if (grid == 0) {
        if (n_in != 22 || out_size != NLAT * DM || ws_size < WS_END2) { fprintf(stderr, "kernel_launch: unexpected problem (n_in %d, out %d, ws %zu < %zu); nothing launched\n", n_in, out_size, ws_size, (size_t)WS_END2); grid = -1; return; }
        int dev = 0, cus = 0, per_cu = 0;
        if (hipGetDevice(&dev) != hipSuccess || hipDeviceGetAttribute(&cus, hipDeviceAttributeMultiprocessorCount, dev) != hipSuccess) { grid = -1; return; }
        if (hipFuncSetAttribute((const void*)fwd_kernel, hipFuncAttributeMaxDynamicSharedMemorySize, LDS_BYTES) != hipSuccess) { fprintf(stderr, "kernel_launch: hipFuncSetAttribute failed\n"); grid = -1; return; }
        if (hipOccupancyMaxActiveBlocksPerMultiprocessor(&per_cu, (const void*)fwd_kernel, NTHR, LDS_BYTES) != hipSuccess || per_cu < 1) { fprintf(stderr, "kernel_launch: occupancy query reports %d blocks per CU\n", per_cu); }
        (void)hipGetLastError();
        grid = cus;
    }
    if (grid < 0) return;
    (void)hipMemsetAsync((char*)d_ws + WS_CTL, 0, CTL_ZERO_BYTES, stream);
    Args a{};
    for (int i = 0; i < 22; ++i) a.in[i] = (const float*)d_in[i];
    a.out = (float*)d_out; a.ws = (unsigned char*)d_ws;
#if MK_ONE_LAUNCH
    a.ph_lo = 0; a.ph_hi = NPHASE;
    hipLaunchKernelGGL(fwd_kernel, dim3(grid), dim3(NTHR), LDS_BYTES, stream, a);
#else
    for (int p = 0; p < NPHASE; ++p) {
        a.ph_lo = p; a.ph_hi = p + 1;
        hipLaunchKernelGGL(fwd_kernel, dim3(grid), dim3(NTHR), LDS_BYTES, stream, a);
    }
#endif
}
```

```cpp
#include <hip/hip_runtime.h>
#include <cstdio>
#include <cstdint>

namespace pg8 {
#define PG8_LAS __attribute__((address_space(3)))
typedef unsigned short bf16_t;
typedef short bf16x8 __attribute__((ext_vector_type(8)));
typedef float f32x4 __attribute__((ext_vector_type(4)));
typedef unsigned u32x4 __attribute__((ext_vector_type(4)));
typedef int i32x4 __attribute__((ext_vector_type(4)));
constexpr int BM = 256, BK = 64, HALF = 128, HTB = HALF * BK * 2  , STAGE_BYTES = 8 * HTB, NXCD = 8, WGM = 8;

__host__ __device__ __forceinline__ int lds_byte(int r, int c) { const int st = (r >> 4) * 2 + (c >> 5), rr = r & 15, cc = c & 31, ob = rr * 64 + cc * 2; return st * 1024 + (ob ^ (((ob >> 9) & 1) << 5)); }
__host__ __device__ __forceinline__ void stage_rc(int b, int& R, int& C) { const int st = b / 1024, sb = b % 1024, swz = sb ^ (((sb >> 9) & 1) << 5); R = (st >> 1) * 16 + swz / 64; C = (st & 1) * 32 + (swz % 64) / 2; }
__host__ __device__ __forceinline__ int perm32(int rho) { const int n = rho >> 4, i = rho & 15; return 8 * (i >> 2) + 4 * n + (i & 3); }

struct Unit { int pm, pn, slot; };
struct Gemm { const bf16_t* A; const bf16_t* Bt; int M, N, K; };
__host__ __device__ __forceinline__ size_t tiled_off(size_t row, int k, int K) { return (((row >> 8) * (size_t)(K >> 6) + (size_t)(k >> 6)) << 14) + ((row & 255) << 6) + (size_t)(k & 63); }

struct StaticOrder {
    int nM, nN, nwg, G, c, pn0; unsigned long long pmap;
    __host__ __device__ void init(int M, int N, int G_, int c_) { nM = M / BM; nN = N / BM; nwg = nM * nN; G = G_; c = c_; pn0 = 0; pmap = 0ull; }
    __host__ __device__ bool next(int i, Unit& u) const {
        const long L = (long)i * G + c; if (L >= nwg) return false;
        int wgid = (int)L; { const int q = nwg / NXCD, r = nwg % NXCD, xcd = wgid % NXCD, off = wgid / NXCD; wgid = (xcd < r ? xcd * (q + 1) : r * (q + 1) + (xcd - r) * q) + off; }
        const int nig = WGM * nN, gid = wgid / nig, fm = gid * WGM, gsz = (nM - fm) < WGM ? (nM - fm) : WGM;
        u.pm = fm + ((wgid % nig) % gsz); { const int ix = (wgid % nig) / gsz; u.pn = pmap ? (int)((pmap >> (4 * ix)) & 15ull) : pn0 + ix; } return true;
    }
    __device__ __forceinline__ void a_ready(const Unit&) const {}
    __device__ __forceinline__ void done(const Unit&) const {}
};


typedef float f32x2c __attribute__((ext_vector_type(2))); typedef __bf16 bf16x2c __attribute__((ext_vector_type(2)));
__device__ __forceinline__ unsigned cvt_pk_bf16(float lo, float hi) { const f32x2c v = {lo, hi}; const bf16x2c b = __builtin_convertvector(v, bf16x2c); return __builtin_bit_cast(unsigned, b); }
typedef float f32x2 __attribute__((ext_vector_type(2)));
__device__ __forceinline__ f32x2 gelu_pk(f32x2 v) {
    const f32x2 av = __builtin_elementwise_abs(v), d = av * 0.2316418882f + 1.0f;
    f32x2 t; t.x = __builtin_amdgcn_rcpf(d.x); t.y = __builtin_amdgcn_rcpf(d.y);
    f32x2 q = t * 0.5307027145f + (-0.7265760135f); q = q * t + 0.7107068705f; q = q * t + (-0.142248368f); q = q * t + 0.127414796f; q = q * t;
    const f32x2 s = (v * v) * (-0.72134752044f);
    f32x2 e; e.x = __builtin_amdgcn_exp2f(s.x); e.y = __builtin_amdgcn_exp2f(s.y);
    const f32x2 m = v * (q * e), r = v - m;
    f32x2 o; o.x = v.x < 0.f ? m.x : r.x; o.y = v.y < 0.f ? m.y : r.y; return o;
}

template <int ACT  > struct EpiBf16 {
    static constexpr bool PERM = true, AFTER_DRAIN = false; static_assert(ACT == 0 || ACT == 1, "EpiBf16: ACT is 0 (none) or 1 (gelu_pk)");
    bf16_t* O; int ldc; const float* bias; int split_cols; size_t split_stride; float scale0;
    __device__ __forceinline__ void operator()(const f32x4 (&acc)[2][2][4][2], const Unit& u, int wr, int wc, int fr, int fq) const {
        const int row0 = u.pm * BM + wr * 64 + fr; int colt = u.pn * BM; bf16_t* base = O;
        float sc = 1.f; if (split_cols) { const int t = colt / split_cols; base += (size_t)t * split_stride; colt -= t * split_cols; if (t == 0) sc = scale0; }
        const int col0 = colt + wc * 32 + 8 * fq, bcol0 = u.pn * BM + wc * 32 + 8 * fq;
        f32x4 bv[2][2];
#pragma unroll
        for (int bj = 0; bj < 2; ++bj)
#pragma unroll
            for (int n = 0; n < 2; ++n) bv[bj][n] = bias ? *(const f32x4*)(bias + bcol0 + bj * HALF + 4 * n) : (f32x4){0.f, 0.f, 0.f, 0.f};
#pragma unroll
        for (int ai = 0; ai < 2; ++ai)
#pragma unroll
            for (int m = 0; m < 4; ++m) { bf16_t* rowp = base + (size_t)(row0 + ai * HALF + m * 16) * ldc + col0;
#pragma unroll
                for (int bj = 0; bj < 2; ++bj) { f32x4 v0 = acc[ai][bj][m][0] + bv[bj][0], v1 = acc[ai][bj][m][1] + bv[bj][1];
                    if (ACT == 1) { f32x2 a = gelu_pk((f32x2){v0[0], v0[1]}), b = gelu_pk((f32x2){v0[2], v0[3]}), c = gelu_pk((f32x2){v1[0], v1[1]}), d = gelu_pk((f32x2){v1[2], v1[3]});
                        v0 = (f32x4){a.x, a.y, b.x, b.y}; v1 = (f32x4){c.x, c.y, d.x, d.y}; }
                    v0 = v0 * sc; v1 = v1 * sc; u32x4 w; w.x = cvt_pk_bf16(v0[0], v0[1]); w.y = cvt_pk_bf16(v0[2], v0[3]); w.z = cvt_pk_bf16(v1[0], v1[1]); w.w = cvt_pk_bf16(v1[2], v1[3]);
                    *(u32x4*)(rowp + bj * HALF) = w; } }
    }
};


template <int MODE> struct AccSel { typedef f32x4 type; };
template <> struct AccSel<1> { typedef i32x4 type; };
typedef int i32x8 __attribute__((ext_vector_type(8)));
template <class Epi, class Sched, bool ALIGN_EPI = false, bool SP2 = false, int MODE = 0>
__device__ __forceinline__ void gemm_phase(PG8_LAS unsigned char* lds, const Gemm g, const Sched& S, const Epi& E) {
    int tid_l = threadIdx.x; asm volatile("" : "+v"(tid_l));
    const int tid = tid_l, wid = __builtin_amdgcn_readfirstlane(tid >> 6), lane = tid & 63, wr = wid >> 2, wc = wid & 3, fr = lane & 15, fq = lane >> 4;
    const int K = g.K, nt = K / BK;
    unsigned voffA, voffB;
    { int R, C; stage_rc(tid * 16, R, C); const int Rb = Epi::PERM ? ((R & ~31) + perm32(R & 31)) : R;
        voffA = (unsigned)(R * BK + C) * 2u; voffB = (unsigned)(Rb * BK + C) * 2u; }
    const size_t kstep = (size_t)(BM * BK * 2);
    const size_t hstep = (size_t)HALF * BK * 2;
    const size_t tstep = (size_t)(K / BK) * kstep;
    const unsigned ldsw = (unsigned)wid * 1024u;
    const int aoff = lds_byte(wr * 64 + fr, fq * 8), boff = lds_byte(wc * 32 + fr, fq * 8);
#define PG8_SA(b, h) (((b) * 2 + (h)) * HTB)
#define PG8_SB(b, h) ((4 + (b) * 2 + (h)) * HTB)
#define PG8_STAGE(bufoff, gbase, voff) do { _Pragma("unroll") for (int _i = 0; _i < 2; ++_i) \
        __builtin_amdgcn_global_load_lds((const unsigned*)((const char*)(gbase) + _i * 8192 + (voff)), (PG8_LAS unsigned*)(lds + (bufoff) + ldsw + _i * 8192), 16, 0, 0); } while (0)
#define PG8_LDA(dst, b, h) do { if constexpr (MODE == 2) { _Pragma("unroll") for (int m = 0; m < 4; ++m) { const i32x4 lo_ = *(const PG8_LAS i32x4*)(lds + PG8_SA(b, h) + aoff + m * 2048), hi_ = *(const PG8_LAS i32x4*)(lds + PG8_SA(b, h) + aoff + m * 2048 + 1024); \
        dst##8[m] = __builtin_shufflevector(lo_, hi_, 0, 1, 2, 3, 4, 5, 6, 7); } } \
    else { _Pragma("unroll") for (int m = 0; m < 4; ++m) _Pragma("unroll") for (int k = 0; k < 2; ++k) dst[m][k] = *(const PG8_LAS bf16x8*)(lds + PG8_SA(b, h) + aoff + m * 2048 + k * 1024); } } while (0)
#define PG8_LDB(dst, b, h) do { if constexpr (MODE == 2) { _Pragma("unroll") for (int n = 0; n < 2; ++n) { const i32x4 lo_ = *(const PG8_LAS i32x4*)(lds + PG8_SB(b, h) + boff + n * 2048), hi_ = *(const PG8_LAS i32x4*)(lds + PG8_SB(b, h) + boff + n * 2048 + 1024); \
        dst##8[n] = __builtin_shufflevector(lo_, hi_, 0, 1, 2, 3, 4, 5, 6, 7); } } \
    else { _Pragma("unroll") for (int n = 0; n < 2; ++n) _Pragma("unroll") for (int k = 0; k < 2; ++k) dst[n][k] = *(const PG8_LAS bf16x8*)(lds + PG8_SB(b, h) + boff + n * 2048 + k * 1024); } } while (0)
#define PG8_MMA(ai, bj, At, Bt) do { __builtin_amdgcn_s_setprio(1); _Pragma("unroll") for (int m = 0; m < 4; ++m) _Pragma("unroll") for (int n = 0; n < 2; ++n) { \
        if constexpr (MODE == 2) acc[ai][bj][m][n] = __builtin_amdgcn_mfma_scale_f32_16x16x128_f8f6f4(Bt##8[n], At##8[m], acc[ai][bj][m][n], 0, 0, 0, 0x7f7f7f7f, 0, 0x7f7f7f7f); \
        else { _Pragma("unroll") for (int k = 0; k < 2; ++k) { \
            if constexpr (MODE == 1) acc[ai][bj][m][n] = __builtin_amdgcn_mfma_i32_16x16x64_i8(__builtin_bit_cast(i32x4, Bt[n][k]), __builtin_bit_cast(i32x4, At[m][k]), acc[ai][bj][m][n], 0, 0, 0); \
            else acc[ai][bj][m][n] = __builtin_amdgcn_mfma_f32_16x16x32_bf16(Bt[n][k], At[m][k], acc[ai][bj][m][n], 0, 0, 0); } } } __builtin_amdgcn_s_setprio(0); } while (0)
#define PG8_WAIT_V(n) asm volatile("s_waitcnt vmcnt(" #n ")" ::: "memory")
#define PG8_WAIT_L(n) asm volatile("s_waitcnt lgkmcnt(" #n ")" ::: "memory")
#define PG8_BAR __builtin_amdgcn_s_barrier()
#define PG8_SCHED __builtin_amdgcn_sched_barrier(0)
    Unit cur, nxt; int ui = 0;
    if (!S.next(0, cur)) return;
    cur.slot = 0;
    typedef typename AccSel<MODE>::type acc_t;
    acc_t acc[2][2][4][2];
#pragma unroll
    for (int a = 0; a < 2; ++a)
#pragma unroll
        for (int b = 0; b < 2; ++b)
#pragma unroll
            for (int m = 0; m < 4; ++m)
#pragma unroll
                for (int n = 0; n < 2; ++n) acc[a][b][m][n] = acc_t{};
    bf16x8 At[4][2], B0[2][2], B1[2][2];
    i32x8 At8[4], B08[2], B18[2];
    const char* cA = (const char*)g.A + (size_t)cur.pm * tstep; const char* cB = (const char*)g.Bt + (size_t)cur.pn * tstep;
    S.a_ready(cur);
    if constexpr (SP2) {
        PG8_STAGE(PG8_SB(0, 0), cB, voffB); PG8_STAGE(PG8_SB(0, 1), cB + hstep, voffB); PG8_STAGE(PG8_SA(0, 0), cA, voffA); PG8_STAGE(PG8_SA(0, 1), cA + hstep, voffA);
        if (wr == 1) PG8_BAR;
        PG8_WAIT_V(2); PG8_BAR;
        PG8_STAGE(PG8_SB(1, 0), cB + kstep, voffB); PG8_STAGE(PG8_SA(1, 0), cA + kstep, voffA); PG8_STAGE(PG8_SB(1, 1), cB + hstep + kstep, voffB);
        PG8_WAIT_V(6); PG8_BAR;
    } else {
        PG8_STAGE(PG8_SB(0, 0), cB, voffB); PG8_STAGE(PG8_SA(0, 0), cA, voffA); PG8_STAGE(PG8_SB(0, 1), cB + hstep, voffB); PG8_STAGE(PG8_SA(0, 1), cA + hstep, voffA);
        if (wr == 1) PG8_BAR;
        PG8_WAIT_V(4); PG8_BAR;
        PG8_STAGE(PG8_SB(1, 0), cB + kstep, voffB); PG8_STAGE(PG8_SA(1, 0), cA + kstep, voffA); PG8_STAGE(PG8_SB(1, 1), cB + hstep + kstep, voffB);
        PG8_WAIT_V(6); PG8_BAR;
    }
    for (;;) {
        const bool has_next = S.next(ui + 1, nxt); nxt.slot = (ui + 1) & 1;
        const char* nA = has_next ? (const char*)g.A + (size_t)nxt.pm * tstep : cA; const char* nB = has_next ? (const char*)g.Bt + (size_t)nxt.pn * tstep : cB;
        for (int t = 0; t < nt; t += 2) {
            const bool last = (t == nt - 2);
            const char* a1 = cA + (size_t)(t + 1) * kstep;
            const char* a2 = last ? nA : cA + (size_t)(t + 2) * kstep; const char* b2 = last ? nB : cB + (size_t)(t + 2) * kstep;
            const char* a3 = a2 + kstep; const char* b3 = b2 + kstep;
            if (last && has_next) S.a_ready(nxt);
            if constexpr (SP2) {
            PG8_LDB(B0, 0, 0); PG8_LDB(B1, 0, 1); PG8_SCHED; PG8_LDA(At, 0, 0); PG8_STAGE(PG8_SA(1, 1), a1 + hstep, voffA);
            PG8_WAIT_V(8); PG8_WAIT_L(0); PG8_BAR; PG8_MMA(0, 0, At, B0); PG8_MMA(0, 1, At, B1); PG8_BAR; PG8_SCHED;
            PG8_LDA(At, 0, 1); PG8_STAGE(PG8_SB(0, 0), b2, voffB); PG8_STAGE(PG8_SB(0, 1), b2 + hstep, voffB); PG8_STAGE(PG8_SA(0, 0), a2, voffA);
            PG8_WAIT_V(8); PG8_WAIT_L(0); PG8_BAR; PG8_MMA(1, 0, At, B0); PG8_MMA(1, 1, At, B1); PG8_BAR; PG8_SCHED;
            PG8_LDB(B0, 1, 0); PG8_LDB(B1, 1, 1); PG8_SCHED; PG8_LDA(At, 1, 0); PG8_STAGE(PG8_SA(0, 1), a2 + hstep, voffA);
            PG8_WAIT_V(8); PG8_WAIT_L(0); PG8_BAR; PG8_MMA(0, 0, At, B0); PG8_MMA(0, 1, At, B1); PG8_BAR; PG8_SCHED;
            PG8_LDA(At, 1, 1); PG8_STAGE(PG8_SB(1, 0), b3, voffB); PG8_STAGE(PG8_SB(1, 1), b3 + hstep, voffB); PG8_STAGE(PG8_SA(1, 0), a3, voffA);
            PG8_WAIT_V(8); PG8_WAIT_L(0); PG8_BAR; PG8_MMA(1, 0, At, B0); PG8_MMA(1, 1, At, B1); PG8_BAR; PG8_SCHED;
            } else {
            PG8_LDB(B0, 0, 0); PG8_SCHED; PG8_LDA(At, 0, 0); PG8_STAGE(PG8_SA(1, 1), a1 + hstep, voffA);
            PG8_WAIT_L(8); PG8_BAR; PG8_WAIT_L(0); PG8_MMA(0, 0, At, B0); PG8_BAR; PG8_SCHED;
            PG8_LDB(B1, 0, 1); PG8_STAGE(PG8_SB(0, 0), b2, voffB);
            PG8_BAR; PG8_WAIT_L(0); PG8_MMA(0, 1, At, B1); PG8_BAR;
            PG8_LDA(At, 0, 1); PG8_STAGE(PG8_SA(0, 0), a2, voffA);
            PG8_BAR; PG8_WAIT_L(0); PG8_MMA(1, 0, At, B0); PG8_BAR; PG8_SCHED;
            PG8_STAGE(PG8_SB(0, 1), b2 + hstep, voffB);
            PG8_WAIT_V(6); PG8_BAR; PG8_MMA(1, 1, At, B1); PG8_BAR;
            PG8_LDB(B0, 1, 0); PG8_SCHED; PG8_LDA(At, 1, 0); PG8_STAGE(PG8_SA(0, 1), a2 + hstep, voffA);
            PG8_WAIT_L(8); PG8_BAR; PG8_WAIT_L(0); PG8_MMA(0, 0, At, B0); PG8_BAR; PG8_SCHED;
            PG8_LDB(B1, 1, 1); PG8_STAGE(PG8_SB(1, 0), b3, voffB);
            PG8_BAR; PG8_WAIT_L(0); PG8_MMA(0, 1, At, B1); PG8_BAR;
            PG8_LDA(At, 1, 1); PG8_STAGE(PG8_SA(1, 0), a3, voffA);
            PG8_BAR; PG8_WAIT_L(0); PG8_MMA(1, 0, At, B0); PG8_BAR; PG8_SCHED;
            PG8_STAGE(PG8_SB(1, 1), b3 + hstep, voffB);
            PG8_WAIT_V(6); PG8_BAR; PG8_MMA(1, 1, At, B1); PG8_BAR;
            }
        }
        if constexpr (ALIGN_EPI) { if (wr == 0) PG8_BAR; }
        if constexpr (!Epi::AFTER_DRAIN) { E(acc, cur, wr, wc, fr, fq); S.done(cur); }
        if (!has_next) break;
#pragma unroll
        for (int a = 0; a < 2; ++a)
#pragma unroll
            for (int b = 0; b < 2; ++b)
#pragma unroll
                for (int m = 0; m < 4; ++m)
#pragma unroll
                    for (int n = 0; n < 2; ++n) acc[a][b][m][n] = acc_t{};
        cur = nxt; cA = nA; cB = nB; ++ui;
        if constexpr (ALIGN_EPI) { if (wr == 1) PG8_BAR; }
    }
    PG8_WAIT_V(0);
    if constexpr (!ALIGN_EPI) { if (wr == 0) PG8_BAR; }
    PG8_BAR;
    if constexpr (Epi::AFTER_DRAIN) { E.fused(acc, cur, wr, wc, fr, fq, lds, wid, lane); S.done(cur); }
#undef PG8_SA
#undef PG8_SB
#undef PG8_STAGE
#undef PG8_LDA
#undef PG8_LDB
#undef PG8_MMA
#undef PG8_WAIT_V
#undef PG8_WAIT_L
#undef PG8_BAR
#undef PG8_SCHED
}
}
#define GAS __attribute__((address_space(1)))
#define LAS __attribute__((address_space(3)))
typedef unsigned short bf16;
typedef unsigned v4u __attribute__((ext_vector_type(4)));
typedef float f32x4 __attribute__((ext_vector_type(4)));
typedef short bf16x8 __attribute__((ext_vector_type(8)));
typedef GAS unsigned gu32;
typedef GAS unsigned long long gu64;
#define RLX_AGENT __ATOMIC_RELAXED, __HIP_MEMORY_SCOPE_AGENT
#define LDS_WAIT() asm volatile("s_waitcnt lgkmcnt(0)" ::: "memory")
#define VM_WAIT() asm volatile("s_waitcnt vmcnt(0)" ::: "memory")
__device__ __forceinline__ unsigned long long rt() { return __builtin_amdgcn_s_memrealtime(); }
__device__ __forceinline__ unsigned f2bf(float f) { unsigned u = __builtin_bit_cast(unsigned, f); return (u + 0x7fffu + ((u >> 16) & 1u)) >> 16; }
typedef float f32x2_t __attribute__((ext_vector_type(2))); typedef __bf16 bf16x2_t __attribute__((ext_vector_type(2)));
__device__ __forceinline__ unsigned pk2(float lo, float hi) { const f32x2_t v = {lo, hi}; const bf16x2_t b = __builtin_convertvector(v, bf16x2_t); return __builtin_bit_cast(unsigned, b); }

#define XB_TMO      128
#define XB_XCNT(j)  (256  + 64 * (j))
#define XB_XSUB(j)  (1280 + 64 * (j))
#define XB_XGEN(j)  (2304 + 64 * (j))
#define XB_TOP      3328
#define XB_TOPGEN   3392
#define XCD_BAR_WORDS 3456
#define XB_SPIN_CAP (1u << 24)

__device__ __forceinline__ unsigned xb_ld(unsigned* p)              { return __hip_atomic_load(p, __ATOMIC_RELAXED, __HIP_MEMORY_SCOPE_AGENT); }
__device__ __forceinline__ unsigned xb_add(unsigned* p, unsigned v) { return __hip_atomic_fetch_add(p, v, __ATOMIC_RELAXED, __HIP_MEMORY_SCOPE_AGENT); }
__device__ __forceinline__ unsigned xb_xcc_id() { return (unsigned)__builtin_amdgcn_s_getreg((3 << 11) | 20) & 0xFu; }
#define XB_SPIN(cond, bar) do { unsigned _sp = 0; while (cond) { __builtin_amdgcn_s_sleep(1); \
    if ((++_sp & 255u) == 0u) { if (xb_ld(&(bar)[XB_TMO])) break; if (_sp > XB_SPIN_CAP) { atomicAdd(&(bar)[XB_TMO], 1u); break; } } } } while (0)

struct XcdBarrier {
    unsigned* bar; unsigned x;
    volatile LAS unsigned* st;
};

__device__ __forceinline__ XcdBarrier xcd_barrier_post(unsigned* bar, volatile LAS unsigned* st) {
    XcdBarrier b; b.bar = bar; b.x = xb_xcc_id(); b.st = st;
    if (threadIdx.x == 0) (void)xb_add(&bar[XB_XCNT(b.x)], 1u);
    return b;
}
__device__ __forceinline__ void xcd_barrier_complete(unsigned* bar, unsigned x, unsigned& nloc, unsigned& nx) {
    const unsigned G = gridDim.x * gridDim.y * gridDim.z;
    unsigned sum, cnt, mine, sp = 0u;
    for (;;) {
        sum = 0u; cnt = 0u; mine = 0u;
#pragma unroll
        for (unsigned j = 0; j < 16; ++j) { const unsigned c = xb_ld(&bar[XB_XCNT(j)]); sum += c; cnt += (c > 0u) ? 1u : 0u; mine = (j == x) ? c : mine; }
        if (sum == G) break;
        __builtin_amdgcn_s_sleep(1);
        if ((++sp & 255u) == 0u) { if (xb_ld(&bar[XB_TMO])) break; if (sp > XB_SPIN_CAP) { atomicAdd(&bar[XB_TMO], 1u); break; } }
    }
    nloc = mine > 0u ? mine : 1u; nx = cnt > 0u ? cnt : 1u;
}

__device__ __forceinline__ void xcd_barrier(const XcdBarrier& b) {
    asm volatile("s_waitcnt vmcnt(0)" ::: "memory");
    __syncthreads();
    if (threadIdx.x == 0) {
        unsigned* bar = b.bar;
        __builtin_amdgcn_s_waitcnt(0);
        unsigned nloc = b.st[0], nx = b.st[1];
        if (nloc == 0u) { xcd_barrier_complete(bar, b.x, nloc, nx); b.st[0] = nloc; b.st[1] = nx; }
        const unsigned old = xb_add(&bar[XB_XSUB(b.x)], 1u);
        const unsigned gen = old / nloc;
        if (old + 1u == (gen + 1u) * nloc) {
            __builtin_amdgcn_fence(__ATOMIC_RELEASE, "agent");
            asm volatile("s_waitcnt vmcnt(0)" ::: "memory");
            const unsigned og = xb_add(&bar[XB_TOP], 1u);
            const unsigned tg = og / nx;
            if (og + 1u == (tg + 1u) * nx) xb_add(&bar[XB_TOPGEN], 1u);
            else XB_SPIN(xb_ld(&bar[XB_TOPGEN]) == tg, bar);
            __builtin_amdgcn_fence(__ATOMIC_ACQUIRE, "agent");
            xb_add(&bar[XB_XGEN(b.x)], 1u);
            asm volatile("s_waitcnt vmcnt(0)" ::: "memory");
        } else {
            XB_SPIN(xb_ld(&bar[XB_XGEN(b.x)]) == gen, bar);
            __builtin_amdgcn_fence(__ATOMIC_ACQUIRE, "agent");
            asm volatile("s_waitcnt vmcnt(0)" ::: "memory");
        }
    }
    __syncthreads();
}

constexpr int DM = 1024, NB = 16, SEQ = 4096, CTXL = 256;
constexpr int NLAT = NB * SEQ;
constexpr int NCTX = NB * CTXL;
constexpr int MROWS = NLAT + NCTX;
constexpr int INC = 3224, ZW = 3328, DFF = 2816;
constexpr int Z_AU = 0, Z_AV = 256, Z_BQ = 512, Z_BK = 896, Z_BV = 1280, Z_CQ = 1664, Z_CK = 2048, Z_CV = 2432, Z_CO = 2816, Z_CG = 3200;
constexpr int Y_A = 0, Y_B = 256, Y_C = 640;
constexpr float EPS = 1e-6f;
constexpr int NWAVES = 8, NTHR = 512;

constexpr size_t MiB = 1u << 20;
constexpr size_t WS_CTL = 0, CTL_ZERO_BYTES = 196608, WS_CMAX = 65536;
constexpr size_t WS_MOD = 1 * MiB;
constexpr size_t WS_CV1 = 2 * MiB;
constexpr size_t WS_CV2 = WS_CV1 + (size_t)2 * 17 * 3328 * 4;
constexpr size_t WS_EV = WS_CV2 + (size_t)2 * 17 * 5632 * 4;
static_assert(WS_EV % 256 == 0 && WS_EV + (size_t)4 * 16 * 3 * 1024 * 4 <= 4 * MiB, "d_ws map (EV)");
constexpr size_t WS_RSQ = 4 * MiB;
constexpr size_t WS_ROWFAC = WS_RSQ + (size_t)5 * 69632 * 4;
static_assert(WS_ROWFAC + (size_t)69632 * 4 <= 6 * MiB, "d_ws map (ROWFAC)");
constexpr size_t WS_WQ = 984 * MiB;
constexpr size_t WQ_BYTES = (size_t)5632 * 1024, WS_SB = WS_WQ + 2 * WQ_BYTES, WS_W8DN = WS_SB + (size_t)2 * 5632 * 4, W8DN_BYTES = (size_t)1024 * 2816, WS_GATE8 = WS_W8DN + 2 * W8DN_BYTES, WS_WQIN = WS_GATE8 + (size_t)2 * 16 * 6144 * 4, WQIN_BYTES = (size_t)3328 * 1024, WS_SBIN = WS_WQIN + 2 * WQIN_BYTES, WS_TOTAL = WS_SBIN + (size_t)2 * 3328 * 4;
constexpr size_t WS_CMAXDN = WS_CMAX + (size_t)2 * 5632 * 4;
constexpr size_t WS_CMAXIN = WS_CMAXDN + (size_t)2 * 1024 * 4;
static_assert(WS_CMAXIN + (size_t)2 * 3328 * 4 <= CTL_ZERO_BYTES, "control region");
constexpr size_t WIN_BYTES = (size_t)3328 * 1024 * 2, WOUT_BYTES = (size_t)1024 * 1024 * 2, WGU_BYTES = (size_t)2 * 2816 * 1024 * 2, WDN_BYTES = (size_t)1024 * 2816 * 2;
constexpr size_t WS_WIN = 6 * MiB;
constexpr size_t WS_WOUT = WS_WIN + 2 * WIN_BYTES;
constexpr size_t WS_WGU = WS_WOUT + 2 * WOUT_BYTES;
constexpr size_t WS_WDN = WS_WGU + 2 * WGU_BYTES;
constexpr size_t WS_XN = WS_WDN + 2 * WDN_BYTES;
constexpr size_t WS_Z = WS_XN + (size_t)69632 * 1024 * 2;
constexpr size_t WS_RB = WS_Z + (size_t)69632 * 3328 * 2;
constexpr size_t WS_QP = WS_RB + (size_t)69632 * 1024 * 2;
constexpr size_t WS_A2 = WS_QP;
static_assert(WS_CV2 + (size_t)2 * 17 * 5632 * 4 <= WS_RSQ && WS_RSQ + (size_t)5 * 69632 * 4 <= WS_WIN && WS_XN == 56 * MiB && WS_Z == 192 * MiB && WS_RB == 634 * MiB && WS_QP == 770 * MiB, "d_ws map");
constexpr int CW_BAR = 4096;

constexpr int RING_BYTES = 131072;
constexpr int LDSCTL_OFF = RING_BYTES, MISC_OFF = LDSCTL_OFF + 320;
constexpr int PRE_OFF = LDSCTL_OFF + 1024;
constexpr int LDS_BYTES = 147456;


__device__ __forceinline__ float bflo(unsigned u) { return __uint_as_float(u << 16); }
__device__ __forceinline__ float bfhi(unsigned u) { return __uint_as_float(u & 0xffff0000u); }
__device__ __forceinline__ float bf2f(bf16 v) { return __uint_as_float(((unsigned)v) << 16); }
__device__ __forceinline__ float sigmoidf_(float x) { return __builtin_amdgcn_rcpf(1.f + __expf(-x)); }
__device__ __forceinline__ float siluf_(float x) { return x * __builtin_amdgcn_rcpf(1.f + __expf(-x)); }
__device__ __forceinline__ float gelu_tanh(float x) { const float u = 0.7978845608028654f * (x + 0.044715f * x * x * x); return x * __builtin_amdgcn_rcpf(1.f + __expf(-2.f * u)); }
__device__ __forceinline__ void unpack16(const v4u a, const v4u b, float (&x)[16]) {
    x[0] = bflo(a.x); x[1] = bfhi(a.x); x[2] = bflo(a.y); x[3] = bfhi(a.y); x[4] = bflo(a.z); x[5] = bfhi(a.z); x[6] = bflo(a.w); x[7] = bfhi(a.w);
    x[8] = bflo(b.x); x[9] = bfhi(b.x); x[10] = bflo(b.y); x[11] = bfhi(b.y); x[12] = bflo(b.z); x[13] = bfhi(b.z); x[14] = bflo(b.w); x[15] = bfhi(b.w);
}
__device__ __forceinline__ float shfl_xor_l(float v, int o, int lane_l) { return __builtin_bit_cast(float, __builtin_amdgcn_ds_bpermute((lane_l ^ o) << 2, __builtin_bit_cast(int, v))); }
__device__ __forceinline__ float wave_sum(float v) {
#pragma unroll
    for (int o = 1; o < 64; o <<= 1) v += __shfl_xor(v, o);
    return v;
}

namespace pg8 {
__device__ __forceinline__ int unit_batch(const Unit& u) { return u.pm < 256 ? (u.pm >> 4) : 16; }
struct PrefOrder : StaticOrder {
    const float* rv; const float* cv; int cvn; PG8_LAS unsigned char* pre;
    __device__ __forceinline__ void a_ready(const Unit& u) const {
        const int wid = __builtin_amdgcn_readfirstlane(threadIdx.x >> 6), lane = threadIdx.x & 63;
        const float* src = (wid < 4) ? rv + (size_t)u.pm * 256 + wid * 64 + lane : cv + (size_t)unit_batch(u) * cvn + (size_t)u.pn * 256 + (wid - 4) * 64 + lane;
        __builtin_amdgcn_global_load_lds((const unsigned*)src, (PG8_LAS unsigned*)(pre + u.slot * 2048 + wid * 256), 4, 0, 0);
    }
};
struct EvOrder : StaticOrder {
    const float* ev; PG8_LAS unsigned char* pre;
    __device__ __forceinline__ void a_ready(const Unit& u) const {
        int t_ = threadIdx.x; asm volatile("" : "+v"(t_));
        const int wid = __builtin_amdgcn_readfirstlane(t_ >> 6), lane = t_ & 63;
        const float* base = ev + (size_t)unit_batch(u) * 3 * 1024 + (size_t)u.pn * 256 + lane;
        __builtin_amdgcn_global_load_lds((const unsigned*)(base + (wid >> 2) * 1024 + (wid & 3) * 64), (PG8_LAS unsigned*)(pre + u.slot * 3072 + wid * 256), 4, 0, 0);
        if (wid < 4) __builtin_amdgcn_global_load_lds((const unsigned*)(base + 2 * 1024 + wid * 64), (PG8_LAS unsigned*)(pre + u.slot * 3072 + (wid + 8) * 256), 4, 0, 0);
    }
};
struct Pref3Order : StaticOrder {
    const float* rv; const float* cv; int cvn; const float* sv; PG8_LAS unsigned char* pre;
    __device__ __forceinline__ void a_ready(const Unit& u) const {
        const int wid = __builtin_amdgcn_readfirstlane(threadIdx.x >> 6), lane = threadIdx.x & 63;
        const float* src = (wid < 4) ? rv + (size_t)u.pm * 256 + wid * 64 + lane : cv + (size_t)unit_batch(u) * cvn + (size_t)u.pn * 256 + (wid - 4) * 64 + lane;
        __builtin_amdgcn_global_load_lds((const unsigned*)src, (PG8_LAS unsigned*)(pre + u.slot * 3072 + wid * 256), 4, 0, 0);
        if (wid < 4) __builtin_amdgcn_global_load_lds((const unsigned*)(sv + (size_t)u.pn * 256 + wid * 64 + lane), (PG8_LAS unsigned*)(pre + u.slot * 3072 + (wid + 8) * 256), 4, 0, 0);
    }
};
__device__ __forceinline__ void unpack8f(const u32x4 t, float (&v)[8]) {
    v[0] = __uint_as_float(t.x << 16); v[1] = __uint_as_float(t.x & 0xffff0000u); v[2] = __uint_as_float(t.y << 16); v[3] = __uint_as_float(t.y & 0xffff0000u);
    v[4] = __uint_as_float(t.z << 16); v[5] = __uint_as_float(t.z & 0xffff0000u); v[6] = __uint_as_float(t.w << 16); v[7] = __uint_as_float(t.w & 0xffff0000u); }
struct EpiZH {
    static constexpr bool PERM = true, AFTER_DRAIN = false;
    bf16_t* ZH; int M; PG8_LAS unsigned char* pre;
    __device__ __forceinline__ void operator()(const f32x4 (&acc)[2][2][4][2], const Unit& u, int wr, int wc, int fr, int fq) const {
        const int row0 = u.pm * BM + wr * 64 + fr; const PG8_LAS float* pv = (const PG8_LAS float*)(pre + u.slot * 2048);
        float rstd[2][4];
#pragma unroll
        for (int ai = 0; ai < 2; ++ai)
#pragma unroll
            for (int m = 0; m < 4; ++m) rstd[ai][m] = __builtin_amdgcn_rsqf(pv[wr * 64 + fr + ai * HALF + m * 16] * (1.f / 1024.f) + 1e-6f);
#pragma unroll
        for (int bj = 0; bj < 2; ++bj) { const int colbase = u.pn * BM + bj * HALF + wc * 32;
            const f32x4 c0 = *(const PG8_LAS f32x4*)(pv + 256 + bj * HALF + wc * 32 + 8 * fq), c1 = *(const PG8_LAS f32x4*)(pv + 256 + bj * HALF + wc * 32 + 8 * fq + 4);
            bf16_t* base = ZH + ((size_t)(colbase >> 6) * M + row0) * 64 + (colbase & 63) + 8 * fq;
#pragma unroll
            for (int ai = 0; ai < 2; ++ai)
#pragma unroll
                for (int m = 0; m < 4; ++m) { const f32x4 v0 = acc[ai][bj][m][0] * rstd[ai][m] + c0, v1 = acc[ai][bj][m][1] * rstd[ai][m] + c1;
                    u32x4 w; w.x = cvt_pk_bf16(v0[0], v0[1]); w.y = cvt_pk_bf16(v0[2], v0[3]); w.z = cvt_pk_bf16(v1[0], v1[1]); w.w = cvt_pk_bf16(v1[2], v1[3]);
                    *(u32x4*)(base + (size_t)(ai * HALF + m * 16) * 64) = w; } }
    }
};

struct EpiZH8 {
    static constexpr bool PERM = true, AFTER_DRAIN = false;
    bf16_t* ZH; int M; PG8_LAS unsigned char* pre;
    __device__ __forceinline__ void operator()(const i32x4 (&acc)[2][2][4][2], const Unit& u, int wr, int wc, int fr, int fq) const {
        const int row0 = u.pm * BM + wr * 64 + fr; const PG8_LAS float* pv = (const PG8_LAS float*)(pre + u.slot * 3072);
        float rf[2][4];
#pragma unroll
        for (int ai = 0; ai < 2; ++ai)
#pragma unroll
            for (int m = 0; m < 4; ++m) rf[ai][m] = pv[wr * 64 + fr + ai * HALF + m * 16];
#pragma unroll
        for (int bj = 0; bj < 2; ++bj) { const int colbase = u.pn * BM + bj * HALF + wc * 32; const int lc = 256 + bj * HALF + wc * 32 + 8 * fq;
            const f32x4 c0 = *(const PG8_LAS f32x4*)(pv + lc), c1 = *(const PG8_LAS f32x4*)(pv + lc + 4), s0 = *(const PG8_LAS f32x4*)(pv + 256 + lc), s1 = *(const PG8_LAS f32x4*)(pv + 256 + lc + 4);
            bf16_t* base = ZH + ((size_t)(colbase >> 6) * M + row0) * 64 + (colbase & 63) + 8 * fq;
#pragma unroll
            for (int ai = 0; ai < 2; ++ai)
#pragma unroll
                for (int m = 0; m < 4; ++m) { const f32x4 v0 = __builtin_convertvector(acc[ai][bj][m][0], f32x4) * (s0 * rf[ai][m]) + c0, v1 = __builtin_convertvector(acc[ai][bj][m][1], f32x4) * (s1 * rf[ai][m]) + c1;
                    u32x4 w; w.x = cvt_pk_bf16(v0[0], v0[1]); w.y = cvt_pk_bf16(v0[2], v0[3]); w.z = cvt_pk_bf16(v1[0], v1[1]); w.w = cvt_pk_bf16(v1[2], v1[3]);
                    *(u32x4*)(base + (size_t)(ai * HALF + m * 16) * 64) = w; } }
    }
};
struct EpiSwiGLU {
    static constexpr bool PERM = true, AFTER_DRAIN = false;
    bf16_t* H; PG8_LAS unsigned char* pre;
    __device__ __forceinline__ void operator()(const f32x4 (&acc)[2][2][4][2], const Unit& u, int wr, int wc, int fr, int fq) const {
        const int row0 = u.pm * BM + wr * 64 + fr, col0 = u.pn * HALF + wc * 32 + 8 * fq; const PG8_LAS float* pv = (const PG8_LAS float*)(pre + u.slot * 2048);
        const PG8_LAS float* cvb = pv + 256 + wc * 32 + 8 * fq;
        const f32x4 cg0 = *(const PG8_LAS f32x4*)cvb, cg1 = *(const PG8_LAS f32x4*)(cvb + 4), cu0 = *(const PG8_LAS f32x4*)(cvb + HALF), cu1 = *(const PG8_LAS f32x4*)(cvb + HALF + 4);
#pragma unroll
        for (int ai = 0; ai < 2; ++ai)
#pragma unroll
            for (int m = 0; m < 4; ++m) { const int row = row0 + ai * HALF + m * 16; const float rstd = __builtin_amdgcn_rsqf(pv[wr * 64 + fr + ai * HALF + m * 16] * (1.f / 1024.f) + 1e-6f);
                const f32x4 g0 = acc[ai][0][m][0] * rstd + cg0, g1 = acc[ai][0][m][1] * rstd + cg1, p0 = acc[ai][1][m][0] * rstd + cu0, p1 = acc[ai][1][m][1] * rstd + cu1;
                const f32x4 t0 = g0 * -1.4426950408889634f, t1 = g1 * -1.4426950408889634f;
                f32x4 e0, e1;
#pragma unroll
                for (int j = 0; j < 4; ++j) { e0[j] = __builtin_amdgcn_exp2f(t0[j]); e1[j] = __builtin_amdgcn_exp2f(t1[j]); }
                const f32x4 d0 = e0 + 1.f, d1 = e1 + 1.f;
                f32x4 r0, r1;
#pragma unroll
                for (int j = 0; j < 4; ++j) { r0[j] = __builtin_amdgcn_rcpf(d0[j]); r1[j] = __builtin_amdgcn_rcpf(d1[j]); }
                const f32x4 h0 = (g0 * p0) * r0, h1 = (g1 * p1) * r1;
                u32x4 w; w.x = cvt_pk_bf16(h0[0], h0[1]); w.y = cvt_pk_bf16(h0[2], h0[3]); w.z = cvt_pk_bf16(h1[0], h1[1]); w.w = cvt_pk_bf16(h1[2], h1[3]);
                *(u32x4*)(H + tiled_off((size_t)row, col0, 2816)) = w; }
    }
};

struct EpiSwiGLU8 {
    static constexpr bool PERM = true, AFTER_DRAIN = false;
    bf16_t* H; PG8_LAS unsigned char* pre;
    __device__ __forceinline__ void operator()(const i32x4 (&acc)[2][2][4][2], const Unit& u, int wr, int wc, int fr, int fq) const {
        const int row0 = u.pm * BM + wr * 64 + fr, col0 = u.pn * HALF + wc * 32 + 8 * fq; const PG8_LAS float* pv = (const PG8_LAS float*)(pre + u.slot * 3072);
        const PG8_LAS float* cvb = pv + 256 + wc * 32 + 8 * fq; const PG8_LAS float* svb = pv + 512 + wc * 32 + 8 * fq;
        const f32x4 cg0 = *(const PG8_LAS f32x4*)cvb, cg1 = *(const PG8_LAS f32x4*)(cvb + 4), cu0 = *(const PG8_LAS f32x4*)(cvb + HALF), cu1 = *(const PG8_LAS f32x4*)(cvb + HALF + 4);
        const f32x4 sg0 = *(const PG8_LAS f32x4*)svb, sg1 = *(const PG8_LAS f32x4*)(svb + 4), su0 = *(const PG8_LAS f32x4*)(svb + HALF), su1 = *(const PG8_LAS f32x4*)(svb + HALF + 4);
#pragma unroll
        for (int ai = 0; ai < 2; ++ai)
#pragma unroll
            for (int m = 0; m < 4; ++m) { const int row = row0 + ai * HALF + m * 16; const float rf = pv[wr * 64 + fr + ai * HALF + m * 16];
                const f32x4 g0 = __builtin_convertvector(acc[ai][0][m][0], f32x4) * (sg0 * rf) + cg0, g1 = __builtin_convertvector(acc[ai][0][m][1], f32x4) * (sg1 * rf) + cg1,
                            p0 = __builtin_convertvector(acc[ai][1][m][0], f32x4) * (su0 * rf) + cu0, p1 = __builtin_convertvector(acc[ai][1][m][1], f32x4) * (su1 * rf) + cu1;
                const f32x4 t0 = g0 * -1.4426950408889634f, t1 = g1 * -1.4426950408889634f;
                f32x4 e0, e1;
#pragma unroll
                for (int j = 0; j < 4; ++j) { e0[j] = __builtin_amdgcn_exp2f(t0[j]); e1[j] = __builtin_amdgcn_exp2f(t1[j]); }
                const f32x4 d0 = e0 + 1.f, d1 = e1 + 1.f;
                f32x4 r0, r1;
#pragma unroll
                for (int j = 0; j < 4; ++j) { r0[j] = __builtin_amdgcn_rcpf(d0[j]); r1[j] = __builtin_amdgcn_rcpf(d1[j]); }
                const f32x4 h0 = (g0 * p0) * r0, h1 = (g1 * p1) * r1;
                if (u.pm < 256) {
                    f32x4 c0, c1;
#pragma unroll
                    for (int q = 0; q < 4; ++q) { c0[q] = __builtin_fminf(__builtin_fmaxf(h0[q], -448.f), 448.f); c1[q] = __builtin_fminf(__builtin_fmaxf(h1[q], -448.f), 448.f); }
                    int p0 = 0, p1 = 0; p0 = __builtin_amdgcn_cvt_pk_fp8_f32(c0[0], c0[1], p0, false); p0 = __builtin_amdgcn_cvt_pk_fp8_f32(c0[2], c0[3], p0, true);
                    p1 = __builtin_amdgcn_cvt_pk_fp8_f32(c1[0], c1[1], p1, false); p1 = __builtin_amdgcn_cvt_pk_fp8_f32(c1[2], c1[3], p1, true);
                    *(unsigned long long*)((unsigned char*)H + 2 * tiled_off((size_t)row, col0 >> 1, 1408)) = (unsigned long long)(unsigned)p0 | ((unsigned long long)(unsigned)p1 << 32);
                } else {
                    u32x4 w; w.x = cvt_pk_bf16(h0[0], h0[1]); w.y = cvt_pk_bf16(h0[2], h0[3]); w.z = cvt_pk_bf16(h1[0], h1[1]); w.w = cvt_pk_bf16(h1[2], h1[3]);
                    *(u32x4*)(H + tiled_off((size_t)row, col0, 2816)) = w; } }
    }
};
__device__ __forceinline__ f32x4 gsafe4(f32x4 v) {
#pragma unroll
    for (int j = 0; j < 4; ++j) v[j] = (__builtin_fabsf(v[j]) < 1e-20f) ? 1e-20f : v[j];
    return v;
}
__device__ __forceinline__ f32x4 rcp4(f32x4 v) { f32x4 r; r[0] = __builtin_amdgcn_rcpf(v[0]); r[1] = __builtin_amdgcn_rcpf(v[1]); r[2] = __builtin_amdgcn_rcpf(v[2]); r[3] = __builtin_amdgcn_rcpf(v[3]); return r; }
struct EpiRes {
    static constexpr bool PERM = true, AFTER_DRAIN = false;
    const bf16_t* Rt;
    bf16_t* Aout;
    int rsq_idx; PG8_LAS unsigned char* pre;
    __device__ __forceinline__ void operator()(const f32x4 (&acc)[2][2][4][2], const Unit& u, int wr, int wc, int fr, int fq) const {
        { int t_ = (int)__builtin_amdgcn_mbcnt_hi(~0u, __builtin_amdgcn_mbcnt_lo(~0u, 0u)); asm volatile("" : "+v"(t_)); fr = t_ & 15; fq = t_ >> 4; }
        const int row0 = u.pm * BM + wr * 64 + fr; const PG8_LAS float* pv = (const PG8_LAS float*)(pre + u.slot * 3072);
        float rs[2][4];
#pragma unroll
        for (int ai = 0; ai < 2; ++ai)
#pragma unroll
            for (int m = 0; m < 4; ++m) rs[ai][m] = 0.f;
#pragma unroll
        for (int bj = 0; bj < 2; ++bj) { const int lc = bj * HALF + wc * 32 + 8 * fq, col0 = u.pn * BM + lc;
            const f32x4 ga = *(const PG8_LAS f32x4*)(pv + lc), gb = *(const PG8_LAS f32x4*)(pv + lc + 4), sa = *(const PG8_LAS f32x4*)(pv + 256 + lc), sb = *(const PG8_LAS f32x4*)(pv + 256 + lc + 4),
                        ia = *(const PG8_LAS f32x4*)(pv + 512 + lc), ib = *(const PG8_LAS f32x4*)(pv + 512 + lc + 4);
#define EPIRES_ROW(ai, m, r0, r1) do { const int row_ = row0 + (ai) * HALF + (m) * 16; \
                const f32x4 x0 = (r0) + ga * acc[ai][bj][m][0], x1 = (r1) + gb * acc[ai][bj][m][1]; \
                rs[ai][m] += (x0[0] * x0[0] + x0[1] * x0[1]) + (x0[2] * x0[2] + x0[3] * x0[3]) + (x1[0] * x1[0] + x1[1] * x1[1]) + (x1[2] * x1[2] + x1[3] * x1[3]); \
                { const f32x4 y0 = x0 * sa, y1 = x1 * sb; u32x4 q_; q_.x = cvt_pk_bf16(y0[0], y0[1]); q_.y = cvt_pk_bf16(y0[2], y0[3]); q_.z = cvt_pk_bf16(y1[0], y1[1]); q_.w = cvt_pk_bf16(y1[2], y1[3]); \
                    *(u32x4*)(Aout + tiled_off((size_t)row_, col0, 1024)) = q_; } } while (0)
            {
#pragma unroll
                for (int ai = 0; ai < 2; ++ai)
#pragma unroll
                    for (int m = 0; m < 4; m += 2) { const u32x4 q0 = *(const u32x4*)(Rt + tiled_off((size_t)(row0 + ai * HALF + m * 16), col0, 1024)), q1 = *(const u32x4*)(Rt + tiled_off((size_t)(row0 + ai * HALF + m * 16 + 16), col0, 1024));
                        { float t[8]; unpack8f(q0, t); const f32x4 r0 = (f32x4){t[0], t[1], t[2], t[3]} * ia, r1 = (f32x4){t[4], t[5], t[6], t[7]} * ib; EPIRES_ROW(ai, m, r0, r1); }
                        { float t[8]; unpack8f(q1, t); const f32x4 r0 = (f32x4){t[0], t[1], t[2], t[3]} * ia, r1 = (f32x4){t[4], t[5], t[6], t[7]} * ib; EPIRES_ROW(ai, m + 1, r0, r1); }
                        asm volatile("" ::: "memory"); }
            }
#undef EPIRES_ROW
        }
        float* rsq;
        { const __attribute__((address_space(4))) unsigned char* kq_ = (const __attribute__((address_space(4))) unsigned char*)__builtin_amdgcn_kernarg_segment_ptr(); asm volatile("" : "+s"(kq_));
          rsq = (float*)((*(unsigned char* const __attribute__((address_space(4)))*)(kq_ + 8 * 23)) + ((size_t)4 << 20)) + (size_t)rsq_idx * 69632; }
#pragma unroll
        for (int ai = 0; ai < 2; ++ai) {
#pragma unroll
            for (int m = 0; m < 4; ++m) { float v = rs[ai][m]; v += __shfl_xor(v, 16); v += __shfl_xor(v, 32); rs[ai][m] = v; }
            const float v = fq == 0 ? rs[ai][0] : fq == 1 ? rs[ai][1] : fq == 2 ? rs[ai][2] : rs[ai][3];
            atomicAdd(rsq + row0 + ai * HALF + fq * 16, v); }
    }
};
}

struct SmallRes { const bf16* Rt; const float* rgn; const float* rscl; bf16* Aout; const float* ogn; const float* oscl; float* rsq; const float* gate; };
__device__ __forceinline__ void ctx_small_gemm(LAS unsigned char* lds, int tid_, const bf16* A, const bf16* Bt, int K, const SmallRes E) {
    typedef short sbf16x8 __attribute__((ext_vector_type(8)));
    constexpr int TS = 144, STG = (64 + 256) * TS;
    const int lane = tid_ & 63, w = __builtin_amdgcn_readfirstlane(tid_ >> 6), r = lane & 15, g = lane >> 4, nkt = K >> 6;
    for (int qu = blockIdx.x; qu < 16 * 4 * 4; qu += gridDim.x) {
        const int pmc = qu >> 4, pn = (qu >> 2) & 3, rq = qu & 3;
        const size_t row_base = (size_t)NLAT + pmc * 256 + rq * 64;
        const bf16* Ap = A + pg8::tiled_off(row_base, 0, K);
        const bf16* Bp = Bt + pg8::tiled_off((size_t)pn * 256, 0, K);
        v4u ra, rb[4];
#define SG_LOAD(kt) do { ra = *(const v4u*)(Ap + (size_t)(kt) * 16384 + tid_ * 8); _Pragma("unroll") for (int i = 0; i < 4; ++i) rb[i] = *(const v4u*)(Bp + (size_t)(kt) * 16384 + (tid_ + 512 * i) * 8); } while (0)
#define SG_STORE(st) do { LAS unsigned char* sb_ = lds + (st) * STG; *(LAS v4u*)(sb_ + (tid_ >> 3) * TS + (tid_ & 7) * 16) = ra; \
        _Pragma("unroll") for (int i = 0; i < 4; ++i) { const int e_ = tid_ + 512 * i; *(LAS v4u*)(sb_ + 64 * TS + (e_ >> 3) * TS + (e_ & 7) * 16) = rb[i]; } } while (0)
        f32x4 acc[4][2];
#pragma unroll
        for (int mt = 0; mt < 4; ++mt)
#pragma unroll
            for (int nt = 0; nt < 2; ++nt) acc[mt][nt] = (f32x4){0.f, 0.f, 0.f, 0.f};
        SG_LOAD(0); SG_STORE(0);
        __syncthreads();
        for (int kt = 0; kt < nkt; ++kt) {
            if (kt + 1 < nkt) SG_LOAD(kt + 1);
            LAS const unsigned char* sa = lds + (kt & 1) * STG; LAS const unsigned char* sbb = sa + 64 * TS;
#pragma unroll
            for (int ks = 0; ks < 2; ++ks) {
                sbf16x8 af[4], bfr[2];
#pragma unroll
                for (int mt = 0; mt < 4; ++mt) af[mt] = *(LAS const sbf16x8*)(sa + (16 * mt + r) * TS + g * 16 + ks * 64);
#pragma unroll
                for (int nt = 0; nt < 2; ++nt) bfr[nt] = *(LAS const sbf16x8*)(sbb + (32 * w + 16 * nt + r) * TS + g * 16 + ks * 64);
#pragma unroll
                for (int mt = 0; mt < 4; ++mt)
#pragma unroll
                    for (int nt = 0; nt < 2; ++nt) acc[mt][nt] = __builtin_amdgcn_mfma_f32_16x16x32_bf16(bfr[nt], af[mt], acc[mt][nt], 0, 0, 0);
            }
            if (kt + 1 < nkt) SG_STORE((kt + 1) & 1);
            __syncthreads();
        }
#undef SG_LOAD
#undef SG_STORE
#pragma unroll
        for (int mt = 0; mt < 4; ++mt) { const size_t row = row_base + 16 * mt + r; float rs = 0.f;
#pragma unroll
            for (int nt = 0; nt < 2; ++nt) { const int col = pn * 256 + 32 * w + 16 * nt + 4 * g; const size_t ro = row * 1024 + col;
                f32x4 res;
                { const unsigned long long t = *(const unsigned long long*)(E.Rt + pg8::tiled_off(row, col, 1024)); const unsigned lo = (unsigned)t, hi = (unsigned)(t >> 32);
                    res = (f32x4){bflo(lo), bfhi(lo), bflo(hi), bfhi(hi)} * pg8::rcp4(pg8::gsafe4(*(const f32x4*)(E.rgn + col) * (*(const f32x4*)(E.rscl + col) + 1.f))); }
                const f32x4 x = res + *(const f32x4*)(E.gate + col) * acc[mt][nt];
                rs += (x[0] * x[0] + x[1] * x[1]) + (x[2] * x[2] + x[3] * x[3]);
                { const f32x4 y = x * pg8::gsafe4(*(const f32x4*)(E.ogn + col) * (*(const f32x4*)(E.oscl + col) + 1.f));
                    *(unsigned long long*)(E.Aout + pg8::tiled_off(row, col, 1024)) = (unsigned long long)pk2(y[0], y[1]) | ((unsigned long long)pk2(y[2], y[3]) << 32); } }
            rs += __shfl_xor(rs, 16); rs += __shfl_xor(rs, 32);
            if (g == 0) atomicAdd(E.rsq + row, rs); }
        __syncthreads();
    }
}

struct Args { const float* in[22]; float* out; unsigned char* ws; int ph_lo, ph_hi; };
static_assert(sizeof(Args) == 22 * 8 + 8 + 8 + 8, "Args has no padding");
enum { I_X = 0, I_C, I_CTX, I_CCTX, I_WMOD, I_BMOD, I_N1G, I_WIN, I_ALNG, I_ALNB, I_AWS, I_ABS, I_RPB, I_CONVW, I_CONVB, I_GATEB, I_WOUT, I_N2G, I_WGATE, I_WUP, I_WDOWN, I_FING };
constexpr int NPHASE = 17;
typedef const __attribute__((address_space(4))) unsigned char* kptr_t;
__device__ __forceinline__ kptr_t kargs() { kptr_t p = (kptr_t)__builtin_amdgcn_kernarg_segment_ptr(); asm volatile("" : "+s"(p)); return p; }
#define KIN(i) (*(const float* const __attribute__((address_space(4)))*)(kp + 8 * (i)))
#define KOUT() (*(float* const __attribute__((address_space(4)))*)(kp + 8 * 22))
#define KWS() (*(unsigned char* const __attribute__((address_space(4)))*)(kp + 8 * 23))

struct Frame {
    LAS unsigned char* lds;
    int tid, lane, wave, G, gw, NGW;
};

__device__ __forceinline__ void p0_transpose_item(const float* W, int K, int N, bf16* WT, int nblk, int item, LAS float* scr, int lane, int grp, int gstride, int goff, unsigned* cmax = nullptr) {
    const int kb = item / nblk, nb = item % nblk, k0 = 64 * kb, n0 = 32 * nb;
    const int nn = n0 + (lane & 31);
#pragma unroll 8
    for (int i = 0; i < 32; ++i) { const int kk = 2 * i + (lane >> 5); scr[kk * 33 + (lane & 31)] = (nn < N) ? W[(size_t)(k0 + kk) * N + nn] : 0.f; }
    LDS_WAIT(); asm volatile("" ::: "memory");
    const int c = lane & 7;
#pragma unroll
    for (int j = 0; j < 4; ++j) { const int n = (lane >> 3) + 8 * j; const LAS float* s = scr + (8 * c) * 33 + n;
        v4u o; o.x = pk2(s[0 * 33], s[1 * 33]); o.y = pk2(s[2 * 33], s[3 * 33]); o.z = pk2(s[4 * 33], s[5 * 33]); o.w = pk2(s[6 * 33], s[7 * 33]);
        const int sn = n0 + n; int dr = grp > 0 ? (sn / grp) * gstride + goff + sn % grp : sn;
        if (grp == -2) { const int g_ = sn >> 6; dr = (g_ < 26 || g_ >= 50 ? g_ : g_ < 38 ? g_ + 12 : g_ - 12) * 64 + (sn & 63); }
        *(GAS v4u*)(WT + pg8::tiled_off((size_t)dr, k0 + 8 * c, K)) = o;
        if (cmax) { float mx = 0.f;
#pragma unroll
            for (int q = 0; q < 8; ++q) mx = fmaxf(mx, __builtin_fabsf(s[q * 33]));
            int lane_l = lane; asm volatile("" : "+v"(lane_l));
            mx = fmaxf(mx, shfl_xor_l(mx, 1, lane_l)); mx = fmaxf(mx, shfl_xor_l(mx, 2, lane_l)); mx = fmaxf(mx, shfl_xor_l(mx, 4, lane_l));
            if (c == 0 && sn < N) atomicMax(cmax + dr, __float_as_uint(mx)); } }
    LDS_WAIT(); asm volatile("" ::: "memory");
}

__device__ __forceinline__ void p0_prologue(Frame& F, kptr_t kp) {
    { float* rz = (float*)(KWS() + WS_RSQ) + MROWS; for (int i = F.gw * 64 + F.lane; i < 4 * MROWS; i += F.NGW * 64) rz[i] = 0.f; }
    {
        LAS float* scr = (LAS float*)(F.lds + F.wave * 16384);
        constexpr int I_IN = 16 * (ZW / 32), I_OUT = 16 * 32, I_G = 16 * (DFF / 32), I_D = (DFF / 64) * 32, PER_L = I_IN + I_OUT + 2 * I_G + I_D;
        for (int it = F.gw; it < 2 * PER_L; it += F.NGW) {
            const int l = it / PER_L; int r = it % PER_L;
            if (r < I_IN) { p0_transpose_item(KIN(I_WIN) + (size_t)l * DM * INC, DM, INC, (bf16*)(KWS() + WS_WIN + l * WIN_BYTES), ZW / 32, r, scr, F.lane, -2, 0, 0, (unsigned*)(KWS() + WS_CMAXIN) + l * 3328); continue; } r -= I_IN;
            if (r < I_OUT) { p0_transpose_item(KIN(I_WOUT) + (size_t)l * DM * DM, DM, DM, (bf16*)(KWS() + WS_WOUT + l * WOUT_BYTES), 32, r, scr, F.lane, 0, 0, 0); continue; } r -= I_OUT;
            if (r < I_G) { p0_transpose_item(KIN(I_WGATE) + (size_t)l * DM * DFF, DM, DFF, (bf16*)(KWS() + WS_WGU + l * WGU_BYTES), DFF / 32, r, scr, F.lane, 128, 256, 0, (unsigned*)(KWS() + WS_CMAX) + l * 5632); continue; } r -= I_G;
            if (r < I_G) { p0_transpose_item(KIN(I_WUP) + (size_t)l * DM * DFF, DM, DFF, (bf16*)(KWS() + WS_WGU + l * WGU_BYTES), DFF / 32, r, scr, F.lane, 128, 256, 128, (unsigned*)(KWS() + WS_CMAX) + l * 5632); continue; } r -= I_G;
            p0_transpose_item(KIN(I_WDOWN) + (size_t)l * DFF * DM, DFF, DM, (bf16*)(KWS() + WS_WDN + l * WDN_BYTES), 32, r, scr, F.lane, 0, 0, 0, (unsigned*)(KWS() + WS_CMAXDN) + l * 1024);
        }
    }
    __syncthreads();
    if ((int)blockIdx.x < 192) {
        LAS float* sc = (LAS float*)F.lds;
        LAS float* part = (LAS float*)(F.lds + 17 * 1024 * 4);
        for (int i = F.tid; i < 17 * 1024; i += NTHR) { const int b = i >> 10, k = i & 1023; const float v = (b < 16) ? KIN(I_C)[b * 1024 + k] : KIN(I_CCTX)[k]; sc[i] = siluf_(v); }
        __syncthreads();
        float* MOD = (float*)(KWS() + WS_MOD);
        for (int unit = blockIdx.x; unit < 192; unit += F.G) {
            const int l = unit / 96, slab = unit % 96, cc = F.tid & 63, kq = F.tid >> 6;
            const float* wp = KIN(I_WMOD) + ((size_t)l * 1024 + kq * 128) * 6144 + slab * 64 + cc;
            float acc[17];
#pragma unroll
            for (int b = 0; b < 17; ++b) acc[b] = 0.f;
#pragma unroll 4
            for (int k = 0; k < 128; ++k) { const float w = wp[(size_t)k * 6144];
#pragma unroll
                for (int b = 0; b < 17; ++b) acc[b] += sc[b * 1024 + kq * 128 + k] * w; }
#pragma unroll
            for (int b = 0; b < 17; ++b) part[(kq * 17 + b) * 64 + cc] = acc[b];
            __syncthreads();
            for (int i = F.tid; i < 17 * 64; i += NTHR) { const int b = i >> 6, c2 = i & 63; float s = KIN(I_BMOD)[l * 6144 + slab * 64 + c2];
#pragma unroll
                for (int q = 0; q < 8; ++q) s += part[(q * 17 + b) * 64 + c2];
                MOD[((size_t)l * 17 + b) * 6144 + slab * 64 + c2] = s; }
            __syncthreads();
        }
    }
}

__device__ __forceinline__ void ld16bf(const bf16* p, float (&v)[16]) {
    const v4u a = *(const v4u*)p, b = *(const v4u*)(p + 8);
    v[0] = bflo(a.x); v[1] = bfhi(a.x); v[2] = bflo(a.y); v[3] = bfhi(a.y); v[4] = bflo(a.z); v[5] = bfhi(a.z); v[6] = bflo(a.w); v[7] = bfhi(a.w);
    v[8] = bflo(b.x); v[9] = bfhi(b.x); v[10] = bflo(b.y); v[11] = bfhi(b.y); v[12] = bflo(b.z); v[13] = bfhi(b.z); v[14] = bflo(b.w); v[15] = bfhi(b.w);
}
__device__ __forceinline__ void st16bf(bf16* p, const float (&v)[16]) {
    v4u a, b; a.x = pk2(v[0], v[1]); a.y = pk2(v[2], v[3]); a.z = pk2(v[4], v[5]); a.w = pk2(v[6], v[7]); b.x = pk2(v[8], v[9]); b.y = pk2(v[10], v[11]); b.z = pk2(v[12], v[13]); b.w = pk2(v[14], v[15]);
    *(v4u*)p = a; *(v4u*)(p + 8) = b;
}


__device__ __forceinline__ void quant_rows_phase(Frame& F, kptr_t kp, size_t src_off, int rsq_idx, int mrows) {
    unsigned char* ws = KWS(); const bf16* A2 = (const bf16*)(ws + src_off); unsigned char* Q = ws + WS_RB; float* rowfac = (float*)(ws + WS_ROWFAC);
    const float* rsq = (const float*)(ws + WS_RSQ) + (size_t)rsq_idx * MROWS;
    int lane_l = F.lane, gw_l = F.gw; asm volatile("" : "+v"(lane_l), "+v"(gw_l));
    const int R = (mrows + F.NGW - 1) / F.NGW, Re = (R + 1) & ~1, r0 = gw_l * Re, r1 = min(r0 + Re, mrows);
    for (int m = r0; m < r1; m += 2) {
        v4u t[2][2]; float rq[2];
#pragma unroll
        for (int i = 0; i < 2; ++i) { const bf16* p = A2 + pg8::tiled_off((size_t)(m + i), 16 * lane_l, DM); t[i][0] = *(const v4u*)p; t[i][1] = *(const v4u*)(p + 8); rq[i] = rsq[m + i]; }
#pragma unroll
        for (int i = 0; i < 2; ++i) { float x[16]; unpack16(t[i][0], t[i][1], x);
            float mx = 0.f;
#pragma unroll
            for (int e = 0; e < 16; ++e) mx = fmaxf(mx, __builtin_fabsf(x[e]));
#pragma unroll
            for (int o = 1; o < 64; o <<= 1) mx = fmaxf(mx, shfl_xor_l(mx, o, lane_l));
            const float s = mx > 0.f ? mx * (1.f / 127.f) : 1.f, inv = 1.f / s;
            unsigned w[4];
#pragma unroll
            for (int j = 0; j < 4; ++j) { unsigned pq = 0;
#pragma unroll
                for (int e = 0; e < 4; ++e) { const int q = (int)__builtin_rintf(x[4 * j + e] * inv); pq |= ((unsigned)q & 255u) << (8 * e); }
                w[j] = pq; }
            v4u o; o.x = w[0]; o.y = w[1]; o.z = w[2]; o.w = w[3];
            *(v4u*)(Q + 2 * pg8::tiled_off((size_t)(m + i), 8 * lane_l, 512)) = o;
            if (lane_l == 0) rowfac[m + i] = __builtin_amdgcn_rsqf(rq[i] * (1.f / DM) + EPS) * s; }
    }
}

__device__ __forceinline__ void ld_row(const float* p, int lane, f32x4 (&v)[4]) {
#pragma unroll
    for (int j = 0; j < 4; ++j) v[j] = *(const f32x4*)(p + 4 * lane + 256 * j);
}
__device__ __forceinline__ float row_sumsq(const f32x4 (&v)[4]) {
    float s = 0.f;
#pragma unroll
    for (int j = 0; j < 4; ++j) s += (v[j].x * v[j].x + v[j].y * v[j].y) + (v[j].z * v[j].z + v[j].w * v[j].w);
    return wave_sum(s);
}
__device__ __forceinline__ void p1_phase(Frame& F, kptr_t kp) {
    unsigned char* ws = KWS();
    const float* MOD = (const float*)(ws + WS_MOD);
    {
        const unsigned* cmax = (const unsigned*)(ws + WS_CMAX); float* SB = (float*)(ws + WS_SB);
        for (int it = blockIdx.x * NTHR + F.tid; it < 2 * 5632 * 64; it += F.G * NTHR) { const int k16 = it & 63, n = (it >> 6) % 5632, l = it / (5632 * 64);
            const float mx = __uint_as_float(cmax[l * 5632 + n]), s = mx > 0.f ? mx * (1.f / 127.f) : 1.f, inv = 1.f / s;
            const bf16* src = (const bf16*)(ws + WS_WGU + l * WGU_BYTES) + pg8::tiled_off((size_t)n, 16 * k16, 1024);
            float x[16]; unpack16(*(const v4u*)src, *(const v4u*)(src + 8), x);
            unsigned w[4];
#pragma unroll
            for (int j = 0; j < 4; ++j) { unsigned p = 0;
#pragma unroll
                for (int e = 0; e < 4; ++e) { int q = (int)__builtin_rintf(x[4 * j + e] * inv); q = q > 127 ? 127 : (q < -127 ? -127 : q); p |= ((unsigned)q & 255u) << (8 * e); }
                w[j] = p; }
            v4u o; o.x = w[0]; o.y = w[1]; o.z = w[2]; o.w = w[3];
            *(v4u*)(ws + WS_WQ + l * WQ_BYTES + 2 * pg8::tiled_off((size_t)n, 8 * k16, 512)) = o;
            if (k16 == 0) SB[l * 5632 + n] = s; }
    }
    {
        const unsigned* cmax = (const unsigned*)(ws + WS_CMAXDN);
        for (int it = blockIdx.x * NTHR + F.tid; it < 2 * 1024 * 88; it += F.G * NTHR) { const int c32 = it % 88, n = (it / 88) & 1023, l = it / (88 * 1024);
            const float mx = __uint_as_float(cmax[l * 1024 + n]), sc = mx > 0.f ? 224.f / mx : 1.f;
            const bf16* src = (const bf16*)(ws + WS_WDN + l * WDN_BYTES) + pg8::tiled_off((size_t)n, 32 * c32, DFF);
            unsigned w[8];
#pragma unroll
            for (int q = 0; q < 2; ++q) { float x[16]; unpack16(*(const v4u*)(src + 16 * q), *(const v4u*)(src + 16 * q + 8), x);
#pragma unroll
                for (int j = 0; j < 4; ++j) { int p = 0; p = __builtin_amdgcn_cvt_pk_fp8_f32(x[4 * j] * sc, x[4 * j + 1] * sc, p, false); p = __builtin_amdgcn_cvt_pk_fp8_f32(x[4 * j + 2] * sc, x[4 * j + 3] * sc, p, true); w[4 * q + j] = (unsigned)p; } }
            unsigned char* dst = ws + WS_W8DN + l * W8DN_BYTES + 2 * pg8::tiled_off((size_t)n, 16 * c32, 1408);
            v4u o0, o1; o0.x = w[0]; o0.y = w[1]; o0.z = w[2]; o0.w = w[3]; o1.x = w[4]; o1.y = w[5]; o1.z = w[6]; o1.w = w[7];
            *(v4u*)dst = o0; *(v4u*)(dst + 16) = o1; }
    }
    {
        float* EV = (float*)(ws + WS_EV); const float* n1 = KIN(I_N1G); const float* n2 = KIN(I_N2G);
        for (int it = blockIdx.x * NTHR + F.tid; it < 4 * 16 * 1024; it += F.G * NTHR) { const int s = it >> 14, b = (it >> 10) & 15, col = it & 1023, l = s >> 1; const bool down = s & 1;
            const float* modl = MOD + (size_t)l * 17 * 6144 + (size_t)b * 6144 + col;
            float gate, og, rg;
            if (!down) { gate = modl[2 * 1024]; og = n2[l * DM + col] * (1.f + modl[4 * 1024]); rg = n1[l * DM + col] * (1.f + modl[1 * 1024]); }
            else { const float mx = __uint_as_float(((const unsigned*)(ws + WS_CMAXDN))[l * 1024 + col]); gate = modl[5 * 1024] * (mx > 0.f ? mx * (1.f / 224.f) : 1.f);
            og = (l == 0) ? n1[DM + col] * (1.f + modl[17 * 6144 + 1 * 1024]) : 1.f; rg = n2[l * DM + col] * (1.f + modl[4 * 1024]); }
            og = (__builtin_fabsf(og) < 1e-20f) ? 1e-20f : og; rg = (__builtin_fabsf(rg) < 1e-20f) ? 1e-20f : rg;
            float* e = EV + ((size_t)(s * 16 + b) * 3) * 1024 + col; e[0] = gate; e[1024] = og; e[2048] = __builtin_amdgcn_rcpf(rg); }
    }
    {
        const unsigned* cmax = (const unsigned*)(ws + WS_CMAXIN); float* SB = (float*)(ws + WS_SBIN);
        for (int it = blockIdx.x * NTHR + F.tid; it < 2 * 3328 * 64; it += F.G * NTHR) { const int k16 = it & 63, n = (it >> 6) % 3328, l = it / (3328 * 64);
            const float mx = __uint_as_float(cmax[l * 3328 + n]), s = mx > 0.f ? mx * (1.f / 127.f) : 1.f, inv = 1.f / s;
            const bf16* src = (const bf16*)(ws + WS_WIN + l * WIN_BYTES) + pg8::tiled_off((size_t)n, 16 * k16, 1024);
            float x[16]; unpack16(*(const v4u*)src, *(const v4u*)(src + 8), x);
            unsigned w[4];
#pragma unroll
            for (int j = 0; j < 4; ++j) { unsigned p = 0;
#pragma unroll
                for (int e = 0; e < 4; ++e) { int q = (int)__builtin_rintf(x[4 * j + e] * inv); q = q > 127 ? 127 : (q < -127 ? -127 : q); p |= ((unsigned)q & 255u) << (8 * e); }
                w[j] = p; }
            v4u o; o.x = w[0]; o.y = w[1]; o.z = w[2]; o.w = w[3];
            *(v4u*)(ws + WS_WQIN + l * WQIN_BYTES + 2 * pg8::tiled_off((size_t)n, 8 * k16, 512)) = o;
            if (k16 == 0) SB[l * 3328 + n] = s; }
    }
    {
        const int set = blockIdx.x & 3, l = set >> 1; const bool second = set & 1; const int NR = second ? 5632 : 3328;
        constexpr int SHS = 2064;
        const float* sh = MOD + (size_t)l * 17 * 6144 + (second ? 3 : 0) * 1024;
        for (int i = F.tid; i < 32 * 128; i += NTHR) { const int b = i >> 7, c8 = i & 127; v4u o = {0u, 0u, 0u, 0u};
            if (b < 17) { const f32x4 p = *(const f32x4*)(sh + (size_t)b * 6144 + c8 * 8), q = *(const f32x4*)(sh + (size_t)b * 6144 + c8 * 8 + 4); o.x = pk2(p.x, p.y); o.y = pk2(p.z, p.w); o.z = pk2(q.x, q.y); o.w = pk2(q.z, q.w); }
            *(LAS v4u*)(F.lds + b * SHS + c8 * 16) = o; }
        __syncthreads();
        const bf16* WT = (const bf16*)(ws + (second ? WS_WGU + l * WGU_BYTES : WS_WIN + l * WIN_BYTES));
        float* dst = (float*)(ws + (second ? WS_CV2 : WS_CV1)) + (size_t)l * 17 * NR;
        const int r = F.lane & 15, g = F.lane >> 4;
        for (int task = (blockIdx.x >> 2) * NWAVES + F.wave; task < NR / 16; task += (F.G >> 2) * NWAVES) {
            const bf16* wp = WT + pg8::tiled_off((size_t)(task * 16 + r), g * 8, 1024);
            f32x4 acc0 = {0.f, 0.f, 0.f, 0.f}, acc1 = acc0;
#pragma unroll 8
            for (int ks = 0; ks < 32; ++ks) { const pg8::bf16x8 a = *(const pg8::bf16x8*)(wp + (size_t)(ks >> 1) * 16384 + (ks & 1) * 32);
                const pg8::bf16x8 b0 = *(LAS const pg8::bf16x8*)(F.lds + r * SHS + g * 16 + ks * 64), b1 = *(LAS const pg8::bf16x8*)(F.lds + (16 + r) * SHS + g * 16 + ks * 64);
                acc0 = __builtin_amdgcn_mfma_f32_16x16x32_bf16(a, b0, acc0, 0, 0, 0); acc1 = __builtin_amdgcn_mfma_f32_16x16x32_bf16(a, b1, acc1, 0, 0, 0); }
            *(f32x4*)(dst + (size_t)r * NR + task * 16 + 4 * g) = acc0;
            if (r == 0) *(f32x4*)(dst + (size_t)16 * NR + task * 16 + 4 * g) = acc1;
        }
        __syncthreads();
    }
    {
        const float* src_lat = KIN(I_X); const float* src_ctx = KIN(I_CTX); const float* gvec = KIN(I_N1G); bf16* A1 = (bf16*)(ws + WS_XN); float* rsq0 = (float*)(ws + WS_RSQ);
        const int R = (MROWS + F.NGW - 1) / F.NGW, Re = (R + 1) & ~1, r0 = F.gw * Re, r1 = min(r0 + Re, MROWS);
        if (r0 >= r1) return;
        unsigned char* A1q = ws + WS_RB; float* rowfac0 = (float*)(ws + WS_ROWFAC); int lane_q = F.lane; asm volatile("" : "+v"(lane_q));
        f32x4 gq[4], gs[4];
#pragma unroll
        for (int j = 0; j < 4; ++j) gq[j] = *(const f32x4*)(gvec + 4 * F.lane + 256 * j);
#define NM_ROWP(m) (((m) < NLAT) ? src_lat + (size_t)(m) * DM : src_ctx + (size_t)((m) - NLAT) * DM)
        f32x4 a[4], c[4], na[4], nc[4]; int bcur = -1;
        ld_row(NM_ROWP(r0), F.lane, a); ld_row(NM_ROWP(r0 + 1), F.lane, c);
        for (int m = r0; m < r1; m += 2) {
            const bool more = m + 2 < r1;
            if (more) { ld_row(NM_ROWP(m + 2), F.lane, na); ld_row(NM_ROWP(m + 3), F.lane, nc); }
            const int b = (m < NLAT) ? (m >> 12) : 16;
            if (b != bcur) { bcur = b; const float* mr = MOD + (size_t)b * 6144 + 1 * 1024;
#pragma unroll
                for (int j = 0; j < 4; ++j) gs[j] = pg8::gsafe4(gq[j] * (*(const f32x4*)(mr + 4 * F.lane + 256 * j) + 1.f)); }
            const float qa = row_sumsq(a), qc = row_sumsq(c);
            if (F.lane == 0) { rsq0[m] = qa; rsq0[m + 1] = qc; }
            f32x4 yv[4], zv[4]; float mxa = 0.f, mxc = 0.f;
#pragma unroll
            for (int j = 0; j < 4; ++j) { const f32x4 y = a[j] * gs[j], z = c[j] * gs[j]; yv[j] = y; zv[j] = z;
                mxa = fmaxf(mxa, fmaxf(fmaxf(__builtin_fabsf(y.x), __builtin_fabsf(y.y)), fmaxf(__builtin_fabsf(y.z), __builtin_fabsf(y.w))));
                mxc = fmaxf(mxc, fmaxf(fmaxf(__builtin_fabsf(z.x), __builtin_fabsf(z.y)), fmaxf(__builtin_fabsf(z.z), __builtin_fabsf(z.w))));
                *(unsigned long long*)(A1 + pg8::tiled_off((size_t)m, 4 * F.lane + 256 * j, DM)) = (unsigned long long)pk2(y.x, y.y) | ((unsigned long long)pk2(y.z, y.w) << 32);
                *(unsigned long long*)(A1 + pg8::tiled_off((size_t)m + 1, 4 * F.lane + 256 * j, DM)) = (unsigned long long)pk2(z.x, z.y) | ((unsigned long long)pk2(z.z, z.w) << 32); }
            {
#pragma unroll
                for (int o = 1; o < 64; o <<= 1) { mxa = fmaxf(mxa, shfl_xor_l(mxa, o, lane_q)); mxc = fmaxf(mxc, shfl_xor_l(mxc, o, lane_q)); }
                const float sa_ = mxa > 0.f ? mxa * (1.f / 127.f) : 1.f, sc_ = mxc > 0.f ? mxc * (1.f / 127.f) : 1.f, ia_ = 1.f / sa_, ic_ = 1.f / sc_;
#pragma unroll
                for (int j = 0; j < 4; ++j) { unsigned pa = 0, pc = 0;
#pragma unroll
                    for (int e = 0; e < 4; ++e) { const int qa_ = (int)__builtin_rintf(yv[j][e] * ia_), qc_ = (int)__builtin_rintf(zv[j][e] * ic_); pa |= ((unsigned)qa_ & 255u) << (8 * e); pc |= ((unsigned)qc_ & 255u) << (8 * e); }
                    *(unsigned*)(A1q + 2 * pg8::tiled_off((size_t)m, (4 * F.lane + 256 * j) >> 1, 512)) = pa; *(unsigned*)(A1q + 2 * pg8::tiled_off((size_t)m + 1, (4 * F.lane + 256 * j) >> 1, 512)) = pc; }
                if (F.lane == 0) { rowfac0[m] = __builtin_amdgcn_rsqf(qa * (1.f / DM) + EPS) * sa_; rowfac0[m + 1] = __builtin_amdgcn_rsqf(qc * (1.f / DM) + EPS) * sc_; } }
            if (more) {
#pragma unroll
                for (int j = 0; j < 4; ++j) { a[j] = na[j]; c[j] = nc[j]; } }
        }
#undef NM_ROWP
    }
}
__device__ __forceinline__ void final_norm_phase(Frame& F, kptr_t kp) {
    unsigned char* ws = KWS(); const bf16* RB = (const bf16*)(ws + WS_RB); const float* rsq = (const float*)(ws + WS_RSQ) + (size_t)4 * MROWS; float* out = KOUT(); const float* gvec = KIN(I_FING);
    const int R = (NLAT + F.NGW - 1) / F.NGW, Re = (R + 3) & ~3, r0 = F.gw * Re, r1 = min(r0 + Re, NLAT);
    if (r0 >= r1) return;
    f32x4 g0[2], g1[2];
#pragma unroll
    for (int p = 0; p < 2; ++p) { g0[p] = *(const f32x4*)(gvec + 512 * p + 8 * F.lane); g1[p] = *(const f32x4*)(gvec + 512 * p + 8 * F.lane + 4); }
    for (int m = r0; m < r1; m += 4) {
        v4u t[4][2]; float rq[4];
#pragma unroll
        for (int i = 0; i < 4; ++i) { rq[i] = rsq[m + i];
#pragma unroll
            for (int p = 0; p < 2; ++p) t[i][p] = *(const v4u*)(RB + pg8::tiled_off((size_t)(m + i), 512 * p + 8 * F.lane, DM)); }
#pragma unroll
        for (int i = 0; i < 4; ++i) { const float rstd = __builtin_amdgcn_rsqf(rq[i] * (1.f / DM) + EPS);
#pragma unroll
            for (int p = 0; p < 2; ++p) { const v4u q = t[i][p]; float* op = out + (size_t)(m + i) * DM + 512 * p + 8 * F.lane;
                *(f32x4*)op = (f32x4){bflo(q.x), bfhi(q.x), bflo(q.y), bfhi(q.y)} * rstd * g0[p]; *(f32x4*)(op + 4) = (f32x4){bflo(q.z), bfhi(q.z), bflo(q.w), bfhi(q.w)} * rstd * g1[p]; } }
    }
}


typedef short mbf16x8 __attribute__((ext_vector_type(8)));
typedef short ms16x4 __attribute__((ext_vector_type(4)));
constexpr int TS64 = 144, TS128 = 272;
constexpr int G_AU = 0, G_AV = 4, G_BQ = 8, G_BK = 14, G_BV = 20, G_CV = 26, G_CO = 32, G_CQ = 38, G_CK = 44, G_CG = 50;
__device__ __forceinline__ const bf16* zh(const bf16* ZH, int grp, size_t row) { return ZH + ((size_t)grp * MROWS + row) * 64; }
template <int KS> __device__ __forceinline__ f32x4 mma16(LAS const unsigned char* ap, LAS const unsigned char* bp, f32x4 acc) {
#pragma unroll
    for (int ks = 0; ks < KS; ++ks) { const mbf16x8 a = *(LAS const mbf16x8*)(ap + ks * 64), b = *(LAS const mbf16x8*)(bp + ks * 64); acc = __builtin_amdgcn_mfma_f32_16x16x32_bf16(a, b, acc, 0, 0, 0); }
    return acc;
}
__device__ __forceinline__ ms16x4 lds_tr4(LAS const unsigned char* p) { return __builtin_bit_cast(ms16x4, __builtin_amdgcn_ds_read_tr16_b64_v4i16((LAS ms16x4*)p)); }
__device__ __forceinline__ unsigned short f2bfs(float f) { return (unsigned short)(pk2(f, 0.f) & 0xffffu); }
__device__ __forceinline__ void unpack8(const v4u t, float (&v)[8]) { v[0] = bflo(t.x); v[1] = bfhi(t.x); v[2] = bflo(t.y); v[3] = bfhi(t.y); v[4] = bflo(t.z); v[5] = bfhi(t.z); v[6] = bflo(t.w); v[7] = bfhi(t.w); }

constexpr size_t WS_KP = WS_QP + (size_t)MROWS * 384 * 2;
constexpr size_t WS_ST = WS_KP + (size_t)MROWS * 384 * 2;
constexpr size_t WS_SN = WS_ST + (size_t)192 * 68 * 4096 * 2;
constexpr size_t WS_GS = WS_SN + (size_t)192 * 68 * 64 * 4;
constexpr size_t WS_CUMG = WS_GS + (size_t)192 * 68 * 4 + 4096;
constexpr size_t WS_LIGG = WS_CUMG + (size_t)192 * 68 * 64 * 4;
constexpr size_t WS_END2 = WS_LIGG + (size_t)192 * 68 * 64 * 4;
static_assert(WS_END2 <= 1024 * MiB && WS_A2 + (size_t)MROWS * DM * 2 <= WS_END2, "d_ws map (mixers)");

__device__ __forceinline__ size_t chunk_row0(int b, int cs) { return cs < 4 ? (size_t)NLAT + b * CTXL + cs * 64 : (size_t)b * SEQ + (cs - 4) * 64; }
__device__ __forceinline__ float lane_shfl(float v, int src) { return __int_as_float(__builtin_amdgcn_ds_bpermute(src << 2, __float_as_int(v))); }
__device__ __forceinline__ float logsigmoidf_(float x) { return fminf(x, 0.f) - __logf(1.f + __expf(-fabsf(x))); }

__device__ __forceinline__ mbf16x8 trfrag(LAS const unsigned char* tile, int k0, int m0, int lane) {
    const int r = lane & 15, g = lane >> 4;
    LAS const unsigned char* p = tile + (k0 + 4 * g + (r >> 2)) * TS64 + (m0 + 4 * (r & 3)) * 2;
    const ms16x4 lo = lds_tr4(p), hi = lds_tr4(p + 16 * TS64);
    return (mbf16x8){lo[0], lo[1], lo[2], lo[3], hi[0], hi[1], hi[2], hi[3]};
}

struct C1Pref { v4u z[6]; v4u v; unsigned short gir, gfr; float gbi, gbf; int okm; };
__device__ __forceinline__ void c1_prefetch(C1Pref& P, const bf16* Z, const float* gb, int tid, int b, int h, int cs) {
    const bool isctx = cs < 4; const size_t row0 = chunk_row0(b, cs); const int t0 = isctx ? cs * 64 : (cs - 4) * 64, slen = isctx ? CTXL : SEQ;
    const size_t seq0 = isctx ? (size_t)NLAT + b * CTXL : (size_t)b * SEQ;
    const int tt = tid >> 3, which = (tid >> 2) & 1, qtr = tid & 3, t = t0 + tt;
    const int zg_ = (which ? G_CK : G_CQ) + h, zo_ = (qtr >> 1) * 32 + (qtr & 1) * 8;
    int okm = 0;
#pragma unroll
    for (int j = 0; j < 3; ++j) { const int ts = t + j - 1; const bool ok = ts >= 0 && ts < slen; const bf16* zp = zh(Z, zg_, seq0 + (ok ? ts : t)) + zo_;
        P.z[2 * j] = *(const v4u*)zp; P.z[2 * j + 1] = *(const v4u*)(zp + 16); okm |= ok ? (1 << j) : 0; }
    P.okm = okm;
    P.v = *(const v4u*)(zh(Z, G_CV + h, row0 + (tid >> 3)) + (tid & 7) * 8);
    if (tid < 128) { const int dir = tid >> 6; const bf16* zg = zh(Z, G_CG, row0 + (tid & 63));
        P.gir = *(const unsigned short*)(zg + (2 * dir) * 6 + h); P.gfr = *(const unsigned short*)(zg + (2 * dir + 1) * 6 + h); P.gbi = gb[(2 * dir) * 6 + h]; P.gbf = gb[(2 * dir + 1) * 6 + h]; }
}
__device__ __forceinline__ mbf16x8 scale_frag(mbf16x8 f, LAS const float* aw, int k0, int g) {
    const f32x4 s0 = *(LAS const f32x4*)(aw + k0 + 4 * g), s1 = *(LAS const f32x4*)(aw + k0 + 16 + 4 * g);
    float x[8]; unpack8(__builtin_bit_cast(v4u, f), x);
    v4u o; o.x = pk2(x[0] * s0[0], x[1] * s0[1]); o.y = pk2(x[2] * s0[2], x[3] * s0[3]); o.z = pk2(x[4] * s1[0], x[5] * s1[1]); o.w = pk2(x[6] * s1[2], x[7] * s1[3]);
    return __builtin_bit_cast(mbf16x8, o);
}
template <int SH>
__device__ __forceinline__ float row_shr_add(float v) {
    return v + __builtin_bit_cast(float, __builtin_amdgcn_update_dpp(0, __builtin_bit_cast(int, v), 0x110 + SH, 0xf, 0xf, false));
}
__device__ __forceinline__ float wave_incl_scan(float x, int lane, float& tot) {
    x = row_shr_add<1>(x); x = row_shr_add<2>(x); x = row_shr_add<4>(x); x = row_shr_add<8>(x);
    const float r0 = __builtin_bit_cast(float, __builtin_amdgcn_readlane(__builtin_bit_cast(int, x), 15)), r1 = __builtin_bit_cast(float, __builtin_amdgcn_readlane(__builtin_bit_cast(int, x), 31)),
                r2 = __builtin_bit_cast(float, __builtin_amdgcn_readlane(__builtin_bit_cast(int, x), 47)), r3 = __builtin_bit_cast(float, __builtin_amdgcn_readlane(__builtin_bit_cast(int, x), 63));
    const int row = lane >> 4; const float off = row == 0 ? 0.f : row == 1 ? r0 : row == 2 ? r0 + r1 : r0 + r1 + r2;
    tot = (r0 + r1) + (r2 + r3);
    return x + off;
}
__device__ __forceinline__ void mixC1_fast(Frame& F, kptr_t kp, int l) {
    unsigned char* ws = KWS();
    const bf16* Z = (const bf16*)(ws + WS_Z); bf16* QP = (bf16*)(ws + WS_QP); bf16* KP = (bf16*)(ws + WS_KP); bf16* ST = (bf16*)(ws + WS_ST); float* SN = (float*)(ws + WS_SN); float* GS = (float*)(ws + WS_GS);
    const float* gb = KIN(I_GATEB) + l * 24;
    constexpr int C1B = 2 * 9216 + 512;
    LAS float* cwl = (LAS float*)(F.lds + 2 * C1B); LAS float* cbl = cwl + 384;
    LAS float* cst = cbl + 128; LAS float* snt = cst + 1024;
    const int h = blockIdx.x % 6, jg = blockIdx.x / 6, nh = (F.G - h + 5) / 6;
    { const float* cw = KIN(I_CONVW) + (size_t)l * 3 * 768; const float* cb = KIN(I_CONVB) + l * 768;
        for (int i = F.tid; i < 384; i += NTHR) { const int j = i >> 7, c = i & 127; cwl[i] = cw[j * 768 + (c >> 6) * 384 + h * 64 + (c & 63)]; }
        if (F.tid < 128) cbl[F.tid] = cb[(F.tid >> 6) * 384 + h * 64 + (F.tid & 63)];
        for (int i = F.tid; i < 1024; i += NTHR) { const int pos = i >> 4, jf = i & 15; const float ang = (float)pos * exp2f(-(float)jf * 0.8304820237218406f); cst[i] = __cosf(ang); snt[i] = __sinf(ang); } }
    __syncthreads();
    const int lane = F.lane, r = lane & 15, g = lane >> 4, w = F.wave;
    const int tt = F.tid >> 3, which = (F.tid >> 2) & 1, qtr = F.tid & 3, half = qtr >> 1, j0 = (qtr & 1) * 8;
    C1Pref P;
    if (jg < 16 * 68) c1_prefetch(P, Z, gb, F.tid, jg / 68, h, jg % 68);
    int it = 0;
    for (int v = jg; v < 16 * 68; v += nh, ++it) {
        const int b = v / 68, cs = v % 68; const bool isctx = cs < 4;
        const size_t row0 = chunk_row0(b, cs); const int t = (isctx ? cs * 64 : (cs - 4) * 64) + tt;
        LAS unsigned char* KT = F.lds + (it & 1) * C1B; LAS unsigned char* VTl = KT + 9216; LAS float* aw = (LAS float*)(KT + 18432);
        C1Pref Pn = P;
        if (v + nh < 16 * 68) c1_prefetch(Pn, Z, gb, F.tid, (v + nh) / 68, h, (v + nh) % 68);
        if (F.tid < 128) { const int dir = F.tid >> 6, tq = F.tid & 63; const float Pgi = bf2f(P.gir) + P.gbi, Pgf = bf2f(P.gfr) + P.gbf; const float xl = logsigmoidf_(Pgf); float tot;
            const float pin = wave_incl_scan(xl, tq, tot); const float x = dir == 0 ? pin : tot - pin + xl;
            aw[F.tid] = __expf(tot - x + Pgi);
            { const size_t gidx = ((size_t)((b * 6 + h) * 2 + dir) * 68 + cs) * 64 + tq; ((float*)(ws + WS_CUMG))[gidx] = x; ((float*)(ws + WS_LIGG))[gidx] = Pgi; }
            if (tq == 0) GS[(size_t)((b * 6 + h) * 2 + dir) * 68 + cs] = __expf(tot); }
        {
            float va[8], vb[8];
            const int cidx = which * 64 + half * 32 + j0;
#pragma unroll
            for (int i = 0; i < 8; ++i) { va[i] = cbl[cidx + i]; vb[i] = cbl[cidx + 16 + i]; }
#pragma unroll
            for (int j = 0; j < 3; ++j) { float x[8], y[8]; const v4u zz = {0u, 0u, 0u, 0u}; const bool okj = (P.okm >> j) & 1; unpack8(okj ? P.z[2 * j] : zz, x); unpack8(okj ? P.z[2 * j + 1] : zz, y);
#pragma unroll
                for (int i = 0; i < 8; ++i) { va[i] += cwl[j * 128 + cidx + i] * x[i]; vb[i] += cwl[j * 128 + cidx + 16 + i] * y[i]; } }
#pragma unroll
            for (int i = 0; i < 8; ++i) { va[i] = siluf_(va[i]); vb[i] = siluf_(vb[i]); }
            if (!isctx) { const int pos = half ? (t & 63) : (t >> 6);
#pragma unroll
                for (int i = 0; i < 8; ++i) { const float c = cst[pos * 16 + j0 + i], s = snt[pos * 16 + j0 + i], x1 = va[i], x2 = vb[i]; va[i] = x1 * c - x2 * s; vb[i] = x1 * s + x2 * c; } }
            if (which) {
#pragma unroll
                for (int i = 0; i < 8; ++i) { va[i] *= 0.125f; vb[i] *= 0.125f; }
            }
            bf16* op = (which ? KP : QP) + ((size_t)h * MROWS + row0 + tt) * 64 + half * 32 + j0;
            v4u oa, ob; oa.x = pk2(va[0], va[1]); oa.y = pk2(va[2], va[3]); oa.z = pk2(va[4], va[5]); oa.w = pk2(va[6], va[7]); ob.x = pk2(vb[0], vb[1]); ob.y = pk2(vb[2], vb[3]); ob.z = pk2(vb[4], vb[5]); ob.w = pk2(vb[6], vb[7]);
            *(v4u*)op = oa; *(v4u*)(op + 16) = ob;
            if (which) { const int co = tt * TS64 + (half * 32 + j0) * 2; *(LAS v4u*)(KT + co) = oa; *(LAS v4u*)(KT + co + 32) = ob; }
            *(LAS v4u*)(VTl + (F.tid >> 3) * TS64 + (F.tid & 7) * 16) = P.v;
        }
        __syncthreads();
        {
            const int dir = w >> 2, mk = w & 3; LAS const float* awd = aw + dir * 64;
            const mbf16x8 a0 = scale_frag(trfrag(KT, 0, 16 * mk, lane), awd, 0, g), a1 = scale_frag(trfrag(KT, 32, 16 * mk, lane), awd, 32, g);
            bf16* stp = ST + ((size_t)((b * 6 + h) * 2 + dir) * 68 + cs) * 4096 + 16 * mk + 4 * g;
            { const v4u onesu = {0x3F803F80u, 0x3F803F80u, 0x3F803F80u, 0x3F803F80u}; const mbf16x8 ones = __builtin_bit_cast(mbf16x8, onesu); f32x4 sn = {0.f, 0.f, 0.f, 0.f};
                sn = __builtin_amdgcn_mfma_f32_16x16x32_bf16(a0, ones, sn, 0, 0, 0); sn = __builtin_amdgcn_mfma_f32_16x16x32_bf16(a1, ones, sn, 0, 0, 0);
                if (r == 0) *(f32x4*)(SN + ((size_t)((b * 6 + h) * 2 + dir) * 68 + cs) * 64 + 16 * mk + 4 * g) = sn; }
#pragma unroll
            for (int nd = 0; nd < 4; ++nd) { f32x4 acc = {0.f, 0.f, 0.f, 0.f};
                acc = __builtin_amdgcn_mfma_f32_16x16x32_bf16(a0, trfrag(VTl, 0, 16 * nd, lane), acc, 0, 0, 0);
                acc = __builtin_amdgcn_mfma_f32_16x16x32_bf16(a1, trfrag(VTl, 32, 16 * nd, lane), acc, 0, 0, 0);
                *(unsigned long long*)(stp + (16 * nd + r) * 64) = (unsigned long long)pk2(acc[0], acc[1]) | ((unsigned long long)pk2(acc[2], acc[3]) << 32); } }
        P = Pn;
    }
}

__device__ __forceinline__ int scan_slot(int dir, int i) { return dir == 0 ? i : (i < 4 ? 3 - i : 71 - i); }
__device__ __forceinline__ void mixC2_fast(Frame& F, kptr_t kp) {
    unsigned char* ws = KWS();
    bf16* ST = (bf16*)(ws + WS_ST); float* SN = (float*)(ws + WS_SN); const float* GS = (const float*)(ws + WS_GS);
    for (int gid = blockIdx.x * NTHR + F.tid; gid < 192 * 512 + 192 * 64; gid += F.G * NTHR) {
        if (gid < 192 * 512) {
            const int chain = gid >> 9, grp = gid & 511, dir = chain & 1;
            bf16* base = ST + (size_t)chain * 68 * 4096 + grp * 8; const float* gsc = GS + chain * 68;
            float s[8]; float zero_ = 0.f; asm volatile("" : "+v"(zero_));
#pragma unroll
            for (int j = 0; j < 8; ++j) s[j] = zero_;
#define C2_BATCH(I0, NB_) do { v4u d[NB_]; float gg[NB_]; \
                _Pragma("unroll") for (int k = 0; k < NB_; ++k) { const int sl = scan_slot(dir, (I0) + k); d[k] = *(const v4u*)(base + (size_t)sl * 4096); gg[k] = gsc[sl]; } \
                _Pragma("unroll") for (int k = 0; k < NB_; ++k) { const int sl = scan_slot(dir, (I0) + k); float x[8]; unpack8(d[k], x); \
                    v4u o; o.x = pk2(s[0], s[1]); o.y = pk2(s[2], s[3]); o.z = pk2(s[4], s[5]); o.w = pk2(s[6], s[7]); \
                    *(v4u*)(base + (size_t)sl * 4096) = o; \
                    _Pragma("unroll") for (int j = 0; j < 8; ++j) s[j] = gg[k] * s[j] + x[j]; } } while (0)
            for (int i0 = 0; i0 < 64; i0 += 8) C2_BATCH(i0, 8);
            C2_BATCH(64, 4);
#undef C2_BATCH
        } else {
            const int e = gid - 192 * 512, chain = e >> 6, dk = e & 63, dir = chain & 1;
            float* base = SN + (size_t)chain * 68 * 64 + dk; const float* gsc = GS + chain * 68; float s = 0.f;
            for (int i0 = 0; i0 < 68; i0 += 17) { float x[17], gq[17];
#pragma unroll
                for (int k = 0; k < 17; ++k) { const int sl = scan_slot(dir, i0 + k); x[k] = base[sl * 64]; gq[k] = gsc[sl]; }
#pragma unroll
                for (int k = 0; k < 17; ++k) { const int sl = scan_slot(dir, i0 + k); base[sl * 64] = s; s = gq[k] * s + x[k]; } }
        }
    }
}

struct C3Pref { v4u q, k, v, sf, sb; float gi, gf, nv; };
__device__ __forceinline__ void c3_prefetch(C3Pref& P, const bf16* Z, const bf16* QP, const bf16* KP, const bf16* ST, const float* SN, const float* CUMp, const float* LIGp, int tid, int b, int h, int cs) {
    const size_t row0 = chunk_row0(b, cs); const int rw = tid >> 3, ch = tid & 7;
    const size_t chf = ((size_t)((b * 6 + h) * 2 + 0) * 68 + cs), chb = chf + 68;
    P.q = *(const v4u*)(QP + ((size_t)h * MROWS + row0 + rw) * 64 + ch * 8); P.k = *(const v4u*)(KP + ((size_t)h * MROWS + row0 + rw) * 64 + ch * 8);
    P.v = *(const v4u*)(zh(Z, G_CV + h, row0 + rw) + ch * 8);
    P.sf = *(const v4u*)(ST + chf * 4096 + rw * 64 + ch * 8); P.sb = *(const v4u*)(ST + chb * 4096 + rw * 64 + ch * 8);
    if (tid < 128) { const int dir = tid >> 6; const size_t gidx = (dir ? chb : chf) * 64 + (tid & 63);
        P.gi = LIGp[gidx]; P.gf = CUMp[gidx];
        P.nv = SN[gidx]; }
}
__device__ __forceinline__ void mixC3_fast(Frame& F, kptr_t kp, int l, bool ctx_out) {
    unsigned char* ws = KWS();
    const bf16* Z = (const bf16*)(ws + WS_Z); const bf16* QP = (const bf16*)(ws + WS_QP); const bf16* KP = (const bf16*)(ws + WS_KP); const bf16* ST = (const bf16*)(ws + WS_ST);
    const float* SN = (const float*)(ws + WS_SN); bf16* Y = (bf16*)(ws + WS_RB);
    const float* CUMp = (const float*)(ws + WS_CUMG); const float* LIGp = (const float*)(ws + WS_LIGG);
    LAS unsigned char* QT = F.lds; LAS unsigned char* KT = F.lds + 9216; LAS unsigned char* VTl = F.lds + 2 * 9216; LAS unsigned char* SF = F.lds + 3 * 9216; LAS unsigned char* SB = F.lds + 4 * 9216;
    LAS float* cum = (LAS float*)(F.lds + 5 * 9216); LAS float* lig = cum + 128; LAS float* nv = lig + 128;
    const int lane = F.lane, r = lane & 15, g = lane >> 4, w = F.wave;
    const int nper = ctx_out ? 68 : 64, nunit = NB * 6 * nper;
    C3Pref P;
#define C3_UNIT(u_, b_, h_, cs_) const int b_ = (u_) / (6 * nper), h_ = ((u_) / nper) % 6, cs_ = ((u_) % nper) + (68 - nper)
    if ((int)blockIdx.x < nunit) { C3_UNIT(blockIdx.x, b0, h0, cs0); c3_prefetch(P, Z, QP, KP, ST, SN, CUMp, LIGp, F.tid, b0, h0, cs0); }
    for (int u = blockIdx.x; u < nunit; u += F.G) {
        C3_UNIT(u, b, h, cs);
        const size_t row0 = chunk_row0(b, cs);
        { const int rw = F.tid >> 3, ch = F.tid & 7, o = rw * TS64 + ch * 16;
            *(LAS v4u*)(QT + o) = P.q; *(LAS v4u*)(KT + o) = P.k; *(LAS v4u*)(VTl + o) = P.v; *(LAS v4u*)(SF + o) = P.sf; *(LAS v4u*)(SB + o) = P.sb; }
        if (F.tid < 128) { const float x = P.gf;
            cum[F.tid] = x; lig[F.tid] = P.gi; nv[F.tid] = P.nv; }
        __syncthreads();
        if (u + F.G < nunit) { C3_UNIT(u + F.G, b1, h1, cs1); c3_prefetch(P, Z, QP, KP, ST, SN, CUMp, LIGp, F.tid, b1, h1, cs1); }
        const int nt = w >> 1, dvh = w & 1, t = 16 * nt + r;
        const bf16* cop = zh(Z, G_CO + h, row0 + t) + 32 * dvh + 4 * g;
        const unsigned long long co0 = *(const unsigned long long*)cop, co1 = *(const unsigned long long*)(cop + 16);
        const mbf16x8 qf0 = *(LAS const mbf16x8*)(QT + t * TS64 + g * 16), qf1 = *(LAS const mbf16x8*)(QT + t * TS64 + g * 16 + 64);
        f32x4 st[4];
#pragma unroll
        for (int mt = 0; mt < 4; ++mt) { LAS const unsigned char* ka = KT + (16 * mt + r) * TS64 + g * 16; f32x4 z0 = {0.f, 0.f, 0.f, 0.f};
            z0 = __builtin_amdgcn_mfma_f32_16x16x32_bf16(*(LAS const mbf16x8*)ka, qf0, z0, 0, 0, 0); st[mt] = __builtin_amdgcn_mfma_f32_16x16x32_bf16(*(LAS const mbf16x8*)(ka + 64), qf1, z0, 0, 0, 0); }
        const float cft = cum[t], cbt = cum[64 + t], wf = __expf(cft), wb = __expf(cbt);
        float pf[16], pb[16], dnf = 0.f, dnb = 0.f;
#pragma unroll
        for (int mt = 0; mt < 4; ++mt) { const int s0 = 16 * mt + 4 * g;
            const f32x4 cfs = *(LAS const f32x4*)(cum + s0), cbs = *(LAS const f32x4*)(cum + 64 + s0), lfs = *(LAS const f32x4*)(lig + s0), lbs = *(LAS const f32x4*)(lig + 64 + s0);
#pragma unroll
            for (int rg = 0; rg < 4; ++rg) { const int sx = s0 + rg;
                const float a = (sx <= t) ? st[mt][rg] * __expf(cft - cfs[rg] + lfs[rg]) : 0.f, c = (sx >= t) ? st[mt][rg] * __expf(cbt - cbs[rg] + lbs[rg]) : 0.f;
                pf[mt * 4 + rg] = a; pb[mt * 4 + rg] = c; dnf += a; dnb += c; } }
        {
            float x[8], y[8]; unpack8(__builtin_bit_cast(v4u, qf0), x); unpack8(__builtin_bit_cast(v4u, qf1), y); float qf_ = 0.f, qb_ = 0.f;
#pragma unroll
            for (int j = 0; j < 8; ++j) { qf_ += x[j] * nv[8 * g + j] + y[j] * nv[32 + 8 * g + j]; qb_ += x[j] * nv[64 + 8 * g + j] + y[j] * nv[96 + 8 * g + j]; }
            dnf += wf * qf_; dnb += wb * qb_; }
        dnf += __shfl_xor(dnf, 16); dnf += __shfl_xor(dnf, 32); dnb += __shfl_xor(dnb, 16); dnb += __shfl_xor(dnb, 32);
        const float rdf = __builtin_amdgcn_rcpf(fmaxf(fabsf(dnf), 1.f)), rdb = __builtin_amdgcn_rcpf(fmaxf(fabsf(dnb), 1.f));
        mbf16x8 pff[2], pbf[2];
#pragma unroll
        for (int ks = 0; ks < 2; ++ks) { v4u a, c;
            a.x = pk2(pf[ks * 8 + 0], pf[ks * 8 + 1]); a.y = pk2(pf[ks * 8 + 2], pf[ks * 8 + 3]); a.z = pk2(pf[ks * 8 + 4], pf[ks * 8 + 5]); a.w = pk2(pf[ks * 8 + 6], pf[ks * 8 + 7]);
            c.x = pk2(pb[ks * 8 + 0], pb[ks * 8 + 1]); c.y = pk2(pb[ks * 8 + 2], pb[ks * 8 + 3]); c.z = pk2(pb[ks * 8 + 4], pb[ks * 8 + 5]); c.w = pk2(pb[ks * 8 + 6], pb[ks * 8 + 7]);
            pff[ks] = __builtin_bit_cast(mbf16x8, a); pbf[ks] = __builtin_bit_cast(mbf16x8, c); }
        bf16* yp = Y + pg8::tiled_off(row0 + t, Y_C + h * 64 + 32 * dvh + 4 * g, DM);
#pragma unroll
        for (int mi = 0; mi < 2; ++mi) { const int md = 2 * dvh + mi;
            const mbf16x8 v0 = trfrag(VTl, 0, 16 * md, lane), v1 = trfrag(VTl, 32, 16 * md, lane);
            f32x4 z0 = {0.f, 0.f, 0.f, 0.f};
            f32x4 inf_ = __builtin_amdgcn_mfma_f32_16x16x32_bf16(v0, pff[0], z0, 0, 0, 0); inf_ = __builtin_amdgcn_mfma_f32_16x16x32_bf16(v1, pff[1], inf_, 0, 0, 0);
            f32x4 inb_ = __builtin_amdgcn_mfma_f32_16x16x32_bf16(v0, pbf[0], z0, 0, 0, 0); inb_ = __builtin_amdgcn_mfma_f32_16x16x32_bf16(v1, pbf[1], inb_, 0, 0, 0);
            LAS const unsigned char* sfa = SF + (16 * md + r) * TS64 + g * 16; LAS const unsigned char* sba = SB + (16 * md + r) * TS64 + g * 16;
            f32x4 itf = __builtin_amdgcn_mfma_f32_16x16x32_bf16(*(LAS const mbf16x8*)sfa, qf0, z0, 0, 0, 0); itf = __builtin_amdgcn_mfma_f32_16x16x32_bf16(*(LAS const mbf16x8*)(sfa + 64), qf1, itf, 0, 0, 0);
            f32x4 itb = __builtin_amdgcn_mfma_f32_16x16x32_bf16(*(LAS const mbf16x8*)sba, qf0, z0, 0, 0, 0); itb = __builtin_amdgcn_mfma_f32_16x16x32_bf16(*(LAS const mbf16x8*)(sba + 64), qf1, itb, 0, 0, 0);
            const unsigned long long cw_ = mi ? co1 : co0; const unsigned clo = (unsigned)cw_, chi = (unsigned)(cw_ >> 32);
            const float cg[4] = {bflo(clo), bfhi(clo), bflo(chi), bfhi(chi)}; float yv[4];
#pragma unroll
            for (int rg = 0; rg < 4; ++rg) yv[rg] = ((inf_[rg] + wf * itf[rg]) * rdf + (inb_[rg] + wb * itb[rg]) * rdb) * sigmoidf_(cg[rg]);
            *(unsigned long long*)(yp + 16 * mi) = (unsigned long long)pk2(yv[0], yv[1]) | ((unsigned long long)pk2(yv[2], yv[3]) << 32); }
        __syncthreads();
    }
#undef C3_UNIT
}

__device__ __forceinline__ void mixA_fast(Frame& F, kptr_t kp, int l, int nchunks) {
    unsigned char* ws = KWS();
    const bf16* Z = (const bf16*)(ws + WS_Z); bf16* Y = (bf16*)(ws + WS_RB);
    LAS unsigned char* WT = F.lds;
    LAS unsigned char* VTa = F.lds + 128 * TS128;
    LAS unsigned char* UT = VTa + 64 * TS128;
    const int bxa = (int)F.G - 1 - (int)blockIdx.x;
    const int gsel = bxa & 3, nblk = F.G >> 2;
    if ((bxa >> 2) >= nchunks) return;
    { const float* wsrc = KIN(I_AWS) + (size_t)(l * 4 + gsel) * 128 * 128;
        for (int i = F.tid; i < 128 * 16; i += NTHR) { const int p = i >> 4, c8 = i & 15; const f32x4 a = *(const f32x4*)(wsrc + p * 128 + c8 * 8), b = *(const f32x4*)(wsrc + p * 128 + c8 * 8 + 4);
            v4u o; o.x = pk2(a.x, a.y); o.y = pk2(a.z, a.w); o.z = pk2(b.x, b.y); o.w = pk2(b.z, b.w); *(LAS v4u*)(WT + p * TS128 + c8 * 16) = o; } }
    const int p = F.tid >> 2, qd = F.tid & 3, lane = F.lane, r = lane & 15, g = lane >> 4, w = F.wave;
    const float* lg = KIN(I_ALNG) + (l * 4 + gsel) * 64 + qd * 16; const float* lb = KIN(I_ALNB) + (l * 4 + gsel) * 64 + qd * 16; const float* bsp = KIN(I_ABS) + (l * 4 + gsel) * 128;
    v4u nv0, nv1, nu0, nu1;
#define MIXA_LOAD(chn) do { const size_t row_ = (size_t)(chn) * 128 + p; const bf16* a_ = zh(Z, G_AV + gsel, row_) + qd * 16; const bf16* b_ = zh(Z, G_AU + gsel, row_) + qd * 16; \
        nv0 = *(const v4u*)a_; nv1 = *(const v4u*)(a_ + 8); nu0 = *(const v4u*)b_; nu1 = *(const v4u*)(b_ + 8); } while (0)
#define MIXA_UN16(a_, b_, v_) do { v_[0] = bflo(a_.x); v_[1] = bfhi(a_.x); v_[2] = bflo(a_.y); v_[3] = bfhi(a_.y); v_[4] = bflo(a_.z); v_[5] = bfhi(a_.z); v_[6] = bflo(a_.w); v_[7] = bfhi(a_.w); \
        v_[8] = bflo(b_.x); v_[9] = bfhi(b_.x); v_[10] = bflo(b_.y); v_[11] = bfhi(b_.y); v_[12] = bflo(b_.z); v_[13] = bfhi(b_.z); v_[14] = bflo(b_.w); v_[15] = bfhi(b_.w); } while (0)
    MIXA_LOAD(bxa >> 2);
    for (int ch = bxa >> 2; ch < nchunks; ch += nblk) {
        const v4u cv0 = nv0, cv1 = nv1, cu0 = nu0, cu1 = nu1;
        if (ch + nblk < nchunks) MIXA_LOAD(ch + nblk);
        { float v[16]; MIXA_UN16(cv0, cv1, v);
            float s = 0.f;
#pragma unroll
            for (int i = 0; i < 16; ++i) { v[i] = gelu_tanh(v[i]); s += v[i]; }
            s += __shfl_xor(s, 1); s += __shfl_xor(s, 2);
            const float mu = s * (1.f / 64.f); float s2 = 0.f;
#pragma unroll
            for (int i = 0; i < 16; ++i) { v[i] -= mu; s2 += v[i] * v[i]; }
            s2 += __shfl_xor(s2, 1); s2 += __shfl_xor(s2, 2);
            const float rstd = __builtin_amdgcn_rsqf(s2 * (1.f / 64.f) + EPS);
#pragma unroll
            for (int i = 0; i < 16; ++i) *(LAS unsigned short*)(VTa + (qd * 16 + i) * TS128 + p * 2) = f2bfs(v[i] * rstd * lg[i] + lb[i]);
            float uu[16]; MIXA_UN16(cu0, cu1, uu);
            v4u a, b; a.x = pk2(gelu_tanh(uu[0]), gelu_tanh(uu[1])); a.y = pk2(gelu_tanh(uu[2]), gelu_tanh(uu[3])); a.z = pk2(gelu_tanh(uu[4]), gelu_tanh(uu[5])); a.w = pk2(gelu_tanh(uu[6]), gelu_tanh(uu[7]));
            b.x = pk2(gelu_tanh(uu[8]), gelu_tanh(uu[9])); b.y = pk2(gelu_tanh(uu[10]), gelu_tanh(uu[11])); b.z = pk2(gelu_tanh(uu[12]), gelu_tanh(uu[13])); b.w = pk2(gelu_tanh(uu[14]), gelu_tanh(uu[15]));
            *(LAS v4u*)(UT + p * TS64 + qd * 32) = a; *(LAS v4u*)(UT + p * TS64 + qd * 32 + 16) = b; }
        __syncthreads();
        { LAS const unsigned char* ap = WT + (16 * w + r) * TS128 + g * 16;
#pragma unroll
            for (int nt = 0; nt < 4; ++nt) { f32x4 acc = {0.f, 0.f, 0.f, 0.f}; acc = mma16<4>(ap, VTa + (16 * nt + r) * TS128 + g * 16, acc);
#pragma unroll
                for (int rg = 0; rg < 4; ++rg) { const int pp = 16 * w + 4 * g + rg; LAS unsigned short* up = (LAS unsigned short*)(UT + pp * TS64 + (16 * nt + r) * 2);
                    *up = f2bfs(bf2f(*up) * (acc[rg] + bsp[pp])); } } }
        __syncthreads();
#pragma unroll
        for (int i = 0; i < 2; ++i) { const int idx = F.tid + i * NTHR, rw = idx >> 3, c8 = idx & 7; *(v4u*)(Y + pg8::tiled_off((size_t)ch * 128 + rw, Y_A + gsel * 64 + c8 * 8, DM)) = *(LAS const v4u*)(UT + rw * TS64 + c8 * 16); }
        __syncthreads();
    }
#undef MIXA_LOAD
#undef MIXA_UN16
}

struct BSt { float m, l; bool fresh; f32x4 ot[4]; };
constexpr float B_SC2 = 0.125f * 1.4426950408889634f;
__device__ __forceinline__ void b_update(BSt& st, float (&v)[16], int n, const mbf16x8* vfr  ) {
    float tmax = v[0];
#pragma unroll
    for (int i = 1; i < 16; ++i) if (i < n) tmax = fmaxf(tmax, v[i]);
    tmax = fmaxf(tmax, __shfl_xor(tmax, 16)); tmax = fmaxf(tmax, __shfl_xor(tmax, 32));
    if (__builtin_expect(st.fresh || __any(tmax > 6.f), 0)) { const float d = st.fresh ? tmax : fmaxf(tmax, 0.f), al = __builtin_amdgcn_exp2f(-d); st.m += d; st.l *= al; st.fresh = false;
#pragma unroll
        for (int md = 0; md < 4; ++md) st.ot[md] = st.ot[md] * al;
#pragma unroll
        for (int i = 0; i < 16; ++i) if (i < n) v[i] -= d; }
    float sum = 0.f;
#pragma unroll
    for (int i = 0; i < 16; ++i) if (i < n) { v[i] = __builtin_amdgcn_exp2f(v[i]); sum += v[i]; }
    st.l += sum;
#pragma unroll
    for (int ks = 0; ks < 2; ++ks) if (ks * 8 < n) {
        v4u pk; pk.x = pk2(v[ks * 8 + 0], v[ks * 8 + 1]); pk.y = pk2(v[ks * 8 + 2], v[ks * 8 + 3]); pk.z = pk2(v[ks * 8 + 4], v[ks * 8 + 5]); pk.w = pk2(v[ks * 8 + 6], v[ks * 8 + 7]);
        const mbf16x8 pb = __builtin_bit_cast(mbf16x8, pk);
#pragma unroll
        for (int md = 0; md < 4; ++md) st.ot[md] = __builtin_amdgcn_mfma_f32_16x16x32_bf16(vfr[ks * 4 + md], pb, st.ot[md], 0, 0, 0); }
}
__device__ __forceinline__ void b_update_w(BSt& st, float (&x)[4], unsigned m01, unsigned m23, const mbf16x8* vfr  ) {
    float tmax = fmaxf(fmaxf(x[0], x[1]), fmaxf(x[2], x[3]));
    tmax = fmaxf(tmax, __shfl_xor(tmax, 16)); tmax = fmaxf(tmax, __shfl_xor(tmax, 32));
    if (__builtin_expect(st.fresh || __any(tmax > 6.f), 0)) { const float d = st.fresh ? tmax : fmaxf(tmax, 0.f), al = __builtin_amdgcn_exp2f(-d); st.m += d; st.l *= al; st.fresh = false;
#pragma unroll
        for (int md = 0; md < 4; ++md) st.ot[md] = st.ot[md] * al;
#pragma unroll
        for (int i = 0; i < 4; ++i) x[i] -= d; }
#pragma unroll
    for (int i = 0; i < 4; ++i) x[i] = __builtin_amdgcn_exp2f(x[i]);
    st.l += (x[0] + x[1]) + (x[2] + x[3]);
    const unsigned e01 = pk2(x[0], x[1]), e23 = pk2(x[2], x[3]);
    v4u pk; pk.x = e01 & m01; pk.y = e23 & m23; pk.z = e01 & ~m01; pk.w = e23 & ~m23;
    const mbf16x8 pb = __builtin_bit_cast(mbf16x8, pk);
#pragma unroll
    for (int md = 0; md < 4; ++md) st.ot[md] = __builtin_amdgcn_mfma_f32_16x16x32_bf16(vfr[md], pb, st.ot[md], 0, 0, 0);
}
template <int NG>
__device__ __forceinline__ void mixB_fast(Frame& F, kptr_t kp, int l, bool ctx_out) {
    unsigned char* ws = KWS();
    const bf16* Z = (const bf16*)(ws + WS_Z); bf16* Y = (bf16*)(ws + WS_RB);
    LAS unsigned char* KB0 = F.lds; LAS unsigned char* VB0 = F.lds + 9216;
    LAS float* rpbs = (LAS float*)(F.lds + 2 * 18432);
    const int lane = F.lane, r = lane & 15, g = lane >> 4, w = F.wave;
    constexpr int UR = 2 * NG, NJ = 64 / UR;
    const int nlat = NB * 6 * NJ, nctx = ctx_out ? NB * 6 : 0;
    const int ldrow = F.tid >> 3, ldch = F.tid & 7;
    v4u kreg, vreg; float rp0 = 0.f, rp1 = 0.f;
#define MIXB_COORD(uu, latv, bv, hv, jrv) do { latv = (uu) < nlat; jrv = 0; if (latv) { bv = (uu) / (6 * NJ); hv = ((uu) / NJ) % 6; jrv = (uu) % NJ; } else { const int v_ = (uu) - nlat; bv = v_ / 6; hv = v_ % 6; } } while (0)
#define MIXB_PREF(latv, bv, hv, jrv) do { const int kmin_ = min(max(UR * (jrv) - 4, 0), 56); \
        const size_t trow_ = (latv) ? (size_t)(bv) * SEQ + kmin_ * 64 + ldrow : (size_t)NLAT + (bv) * CTXL + ldrow; \
        kreg = *(const v4u*)(zh(Z, G_BK + (hv), trow_) + ldch * 8); vreg = *(const v4u*)(zh(Z, G_BV + (hv), trow_) + ldch * 8); \
        if (latv) { const float* rp_ = KIN(I_RPB) + (size_t)(l * 6 + (hv)) * 465; const int i0_ = F.tid, i1_ = F.tid + NTHR; \
            const int dc0_ = (i0_ & 63) - 31, dc1_ = (i1_ & 63) - 31; \
            rp0 = (dc0_ >= -15 && dc0_ <= 15) ? 1.4426950408889634f * rp_[(i0_ >> 6) * 31 + dc0_ + 15] : -1e30f; \
            rp1 = (i1_ < 15 * 64 && dc1_ >= -15 && dc1_ <= 15) ? 1.4426950408889634f * rp_[(i1_ >> 6) * 31 + dc1_ + 15] : -1e30f; } } while (0)
    { const int u0 = blockIdx.x; if (u0 < nlat + nctx) { bool lat0; int b0, h0, jr0; MIXB_COORD(u0, lat0, b0, h0, jr0); MIXB_PREF(lat0, b0, h0, jr0); } }
    for (int u = blockIdx.x; u < nlat + nctx; u += F.G) {
        bool lat; int b, h, jr;
        MIXB_COORD(u, lat, b, h, jr);
        const int ngact = lat ? NG : 2;
        const int rrh = w >> 2, cg = w & 3, qr0 = UR * jr + NG * rrh, c0 = 16 * cg, c = c0 + r;
        const size_t qrow0 = lat ? (size_t)b * SEQ + qr0 * 64 + c : (size_t)NLAT + b * CTXL + 32 * w + r;
        const int qstride = lat ? 64 : 16;
        const int kc_lo = (cg == 0) ? 0 : (cg == 1) ? 8 : (cg == 2) ? 24 : 32, kcq = min(max(c - 8, 0), 48);
        const int kmin = min(max(UR * jr - 4, 0), 56), kmax = min(max(UR * jr + UR - 1 - 4, 0), 56) + 7;
        const int nwin = lat ? (kmax - kmin + 1) : 0, ntile = nwin + 4;
        mbf16x8 qf[NG][2];
#pragma unroll
        for (int gi = 0; gi < NG; ++gi) { const bf16* qp = zh(Z, G_BQ + h, qrow0 + (size_t)(gi < ngact ? gi : 0) * qstride) + g * 8;
#pragma unroll
            for (int k2 = 0; k2 < 2; ++k2) { float x[8]; unpack8(*(const v4u*)(qp + 32 * k2), x); v4u o; o.x = pk2(x[0] * B_SC2, x[1] * B_SC2); o.y = pk2(x[2] * B_SC2, x[3] * B_SC2); o.z = pk2(x[4] * B_SC2, x[5] * B_SC2); o.w = pk2(x[6] * B_SC2, x[7] * B_SC2);
                qf[gi][k2] = __builtin_bit_cast(mbf16x8, o); } }
        int idq[4]; unsigned m01 = 0u, m23 = 0u; const int drel = kcq - kc_lo - 4 * g;
#pragma unroll
        for (int i = 0; i < 4; ++i) { const int kc = kc_lo + 4 * g + i + (i >= drel ? 0 : 16); idq[i] = kc - c + 31; }
        m01 = (0 >= drel ? 0xffffu : 0u) | (1 >= drel ? 0xffff0000u : 0u); m23 = (2 >= drel ? 0xffffu : 0u) | (3 >= drel ? 0xffff0000u : 0u);
        if (lat) { rpbs[F.tid] = rp0; if (F.tid + NTHR < 15 * 64) rpbs[F.tid + NTHR] = rp1; }
#define MIXB_LOAD(ti) do { const size_t trow = ((ti) < nwin) ? (size_t)b * SEQ + (kmin + (ti)) * 64 + ldrow : (size_t)NLAT + b * CTXL + ((ti) - nwin) * 64 + ldrow; \
        kreg = *(const v4u*)(zh(Z, G_BK + h, trow) + ldch * 8); vreg = *(const v4u*)(zh(Z, G_BV + h, trow) + ldch * 8); } while (0)
#define MIXB_STORE(bufi) do { *(LAS v4u*)(KB0 + (bufi) * 18432 + ldrow * TS64 + ldch * 16) = kreg; *(LAS v4u*)(VB0 + (bufi) * 18432 + ldrow * TS64 + ldch * 16) = vreg; } while (0)
        MIXB_STORE(0);
        __syncthreads();
        BSt st[NG];
#pragma unroll
        for (int gi = 0; gi < NG; ++gi) { st[gi].m = 0.f; st[gi].l = 0.f; st[gi].fresh = true;
#pragma unroll
            for (int md = 0; md < 4; ++md) st[gi].ot[md] = (f32x4){0.f, 0.f, 0.f, 0.f}; }
        for (int ti = 0; ti < ntile; ++ti) {
            const int buf = ti & 1;
            if (ti + 1 < ntile) MIXB_LOAD(ti + 1);
            else if (u + F.G < nlat + nctx) { bool latn; int bn, hn, jrn; MIXB_COORD(u + F.G, latn, bn, hn, jrn); MIXB_PREF(latn, bn, hn, jrn); }
            LAS const unsigned char* kb = KB0 + buf * 18432; LAS const unsigned char* vb = VB0 + buf * 18432;
            if (ti < nwin) {
                const int kr = kmin + ti;
                const int klo = min(max(qr0 - 4, 0), 56), khi = min(max(qr0 + NG - 1 - 4, 0), 56) + 7;
                if (kr >= klo && kr <= khi) {
                    mbf16x8 kf[2][2], vfr[4];
#pragma unroll
                    for (int mt = 0; mt < 2; ++mt) { LAS const unsigned char* ka = kb + (kc_lo + 16 * mt + r) * TS64 + g * 16; kf[mt][0] = *(LAS const mbf16x8*)ka; kf[mt][1] = *(LAS const mbf16x8*)(ka + 64); }
#pragma unroll
                    for (int md = 0; md < 4; ++md) vfr[md] = trfrag(vb, kc_lo, 16 * md, lane);
#pragma unroll
                    for (int gi = 0; gi < NG; ++gi) { const int qr = qr0 + gi, k0 = min(max(qr - 4, 0), 56);
                        if (kr >= k0 && kr < k0 + 8) { float x[4]; LAS const float* rowp = rpbs + (kr - qr + 7) * 64;
                            const float nm = -st[gi].m; f32x4 za = {nm, nm, nm, nm}, zb = za;
                            za = __builtin_amdgcn_mfma_f32_16x16x32_bf16(kf[0][0], qf[gi][0], za, 0, 0, 0); za = __builtin_amdgcn_mfma_f32_16x16x32_bf16(kf[0][1], qf[gi][1], za, 0, 0, 0);
                            zb = __builtin_amdgcn_mfma_f32_16x16x32_bf16(kf[1][0], qf[gi][0], zb, 0, 0, 0); zb = __builtin_amdgcn_mfma_f32_16x16x32_bf16(kf[1][1], qf[gi][1], zb, 0, 0, 0);
#pragma unroll
                            for (int rg = 0; rg < 4; ++rg) x[rg] = (rg >= drel ? za[rg] : zb[rg]) + rowp[idq[rg]];
                            b_update_w(st[gi], x, m01, m23, vfr); } }
                }
            } else {
                mbf16x8 kf[4][2], vfr[8];
#pragma unroll
                for (int mt = 0; mt < 4; ++mt) { LAS const unsigned char* ka = kb + (16 * mt + r) * TS64 + g * 16; kf[mt][0] = *(LAS const mbf16x8*)ka; kf[mt][1] = *(LAS const mbf16x8*)(ka + 64); }
#pragma unroll
                for (int ks = 0; ks < 2; ++ks)
#pragma unroll
                    for (int md = 0; md < 4; ++md) vfr[ks * 4 + md] = trfrag(vb, 32 * ks, 16 * md, lane);
#pragma unroll
                for (int gi = 0; gi < NG; ++gi) if (gi < ngact) { float v[16];
#pragma unroll
                    for (int mt = 0; mt < 4; ++mt) { const float nm = -st[gi].m; f32x4 z0 = {nm, nm, nm, nm}; z0 = __builtin_amdgcn_mfma_f32_16x16x32_bf16(kf[mt][0], qf[gi][0], z0, 0, 0, 0); z0 = __builtin_amdgcn_mfma_f32_16x16x32_bf16(kf[mt][1], qf[gi][1], z0, 0, 0, 0);
#pragma unroll
                        for (int rg = 0; rg < 4; ++rg) v[mt * 4 + rg] = z0[rg]; }
                    b_update(st[gi], v, 16, vfr); }
            }
            if (ti + 1 < ntile) MIXB_STORE(buf ^ 1);
            __syncthreads();
        }
#undef MIXB_LOAD
#undef MIXB_STORE
#pragma unroll
        for (int gi = 0; gi < NG; ++gi) if (gi < ngact) { float ls = st[gi].l; ls += __shfl_xor(ls, 16); ls += __shfl_xor(ls, 32); const float inv = __builtin_amdgcn_rcpf(ls);
            bf16* yp = Y + pg8::tiled_off(qrow0 + (size_t)gi * qstride, Y_B + h * 64 + 4 * g, DM);
#pragma unroll
            for (int md = 0; md < 4; ++md) *(unsigned long long*)(yp + 16 * md) = (unsigned long long)pk2(st[gi].ot[md][0] * inv, st[gi].ot[md][1] * inv) | ((unsigned long long)pk2(st[gi].ot[md][2] * inv, st[gi].ot[md][3] * inv) << 32); }
    }
#undef MIXB_COORD
#undef MIXB_PREF
}
#ifndef IN_NI8
#define IN_NI8 9
#define IN_I8MAP 0x876543210ull
#define IN_BFMAP 0xCBA9ull
#endif
#ifndef MIXB_NG
#define MIXB_NG 2
#endif
#ifndef MIXA_FAST
#define MIXA_FAST 1
#endif
#ifndef MIXB_FAST
#define MIXB_FAST 1
#endif
#ifndef MIXC_FAST
#define MIXC_FAST 1
#endif
#define PH_LO() (*(const int __attribute__((address_space(4)))*)(kp + 8 * 24))
#define PH_HI() (*(const int __attribute__((address_space(4)))*)(kp + 8 * 24 + 4))
__device__ __forceinline__ void frame_init(Frame& F, LAS unsigned char* lds) {
    int tid_l = threadIdx.x; asm volatile("" : "+v"(tid_l));
    F.lds = lds; F.tid = tid_l; F.lane = F.tid & 63; F.wave = __builtin_amdgcn_readfirstlane(F.tid >> 6);
    F.G = gridDim.x; F.gw = blockIdx.x * NWAVES + F.wave; F.NGW = F.G * NWAVES;
}
__global__ void __launch_bounds__(NTHR, 2) fwd_kernel(Args a_unused) {
    extern __shared__ __attribute__((aligned(16))) unsigned char lds_raw[];
    LAS unsigned char* const lds = (LAS unsigned char*)lds_raw;
    volatile LAS unsigned* MISC = (volatile LAS unsigned*)(lds + MISC_OFF);
    for (int u = threadIdx.x; u < (LDS_BYTES - LDSCTL_OFF) / 4; u += NTHR) ((LAS unsigned*)(lds + LDSCTL_OFF))[u] = 0u;
    __syncthreads();
    int lo, hi; XcdBarrier bar;
    { kptr_t kp = kargs(); lo = PH_LO(); hi = PH_HI(); unsigned* barw = (unsigned*)(KWS() + WS_CTL) + CW_BAR;
      bar.bar = barw; bar.x = 0; bar.st = nullptr;
      if (hi - lo > 1) bar = xcd_barrier_post(barw, MISC + 8); bar.bar = nullptr; }
#define IN(k) (lo <= (k) && (k) < hi)
#define XBAR() do { kptr_t kq_ = kargs(); XcdBarrier b_ = bar; b_.bar = (unsigned*)((*(unsigned char* const __attribute__((address_space(4)))*)(kq_ + 8 * 23)) + WS_CTL) + CW_BAR; xcd_barrier(b_); } while (0)
#define SEAM(k) do { if (IN(k) && IN((k) + 1)) XBAR(); } while (0)

    if (IN(0)) { kptr_t kp = kargs(); Frame F; frame_init(F, lds); p0_prologue(F, kp); SEAM(0); }
    if (IN(1)) { kptr_t kp = kargs(); Frame F; frame_init(F, lds); p1_phase(F, kp); SEAM(1); }

    for (int l = 0; l < 2; ++l) {
        const int pb = 2 + 7 * l;
        if (IN(pb + 0)) { kptr_t kp = kargs(); unsigned char* ws = KWS();
            if (l != 0) { { Frame F; frame_init(F, lds); quant_rows_phase(F, kp, WS_XN, 2 * l, MROWS); }
                __syncthreads(); XBAR(); }
            constexpr int NI8 = IN_NI8, NBF = 13 - IN_NI8, U8 = (MROWS / 256) * NI8;
            { pg8::Gemm g{(const bf16*)(ws + WS_RB), (const bf16*)(ws + WS_WQIN + l * WQIN_BYTES), MROWS, NI8 * 256, DM / 2}; pg8::Pref3Order S; int bid8 = (int)blockIdx.x; asm volatile("" : "+s"(bid8)); S.init(MROWS, NI8 * 256, (int)gridDim.x, bid8); S.pmap = IN_I8MAP;
              S.rv = (const float*)(ws + WS_ROWFAC); S.cv = (const float*)(ws + WS_CV1) + (size_t)l * 17 * 3328; S.cvn = 3328; S.sv = (const float*)(ws + WS_SBIN) + (size_t)l * 3328; S.pre = lds + PRE_OFF;
              pg8::EpiZH8 E{(bf16*)(ws + WS_Z), MROWS, lds + PRE_OFF};
              pg8::gemm_phase<pg8::EpiZH8, pg8::Pref3Order, true, true, 1>(lds, g, S, E); }
            __syncthreads();
            { int bid = (int)blockIdx.x; asm volatile("" : "+s"(bid)); const int G_ = (int)gridDim.x, rot = (G_ % 8 == 0) ? ((U8 % G_) / 8) * 8 : 0, cr = (bid + G_ - rot) % G_;
              pg8::Gemm g{(const bf16*)(ws + WS_XN), (const bf16*)(ws + WS_WIN + l * WIN_BYTES), MROWS, NBF * 256, DM}; pg8::PrefOrder S; S.init(MROWS, NBF * 256, G_, cr); S.pmap = IN_BFMAP;
              S.rv = (const float*)(ws + WS_RSQ) + (size_t)(2 * l) * MROWS; S.cv = (const float*)(ws + WS_CV1) + (size_t)l * 17 * 3328; S.cvn = 3328; S.pre = lds + PRE_OFF;
              pg8::EpiZH E{(bf16*)(ws + WS_Z), MROWS, lds + PRE_OFF};
              pg8::gemm_phase<pg8::EpiZH, pg8::PrefOrder, true, true>(lds, g, S, E); }
            SEAM(pb + 0);
        }
        if (IN(pb + 1)) { kptr_t kp = kargs(); Frame F; frame_init(F, lds);
            const bool ctx_out = (l == 0); const int mrows = ctx_out ? MROWS : NLAT;
            mixC1_fast(F, kp, l);
            __syncthreads();
            mixA_fast(F, kp, l, mrows / 128);
            __syncthreads();
            mixB_fast<MIXB_NG>(F, kp, l, ctx_out);
            SEAM(pb + 1);
        }
        if (IN(pb + 2)) { kptr_t kp = kargs(); Frame F; frame_init(F, lds); mixC2_fast(F, kp); SEAM(pb + 2); }
        if (IN(pb + 3)) { kptr_t kp = kargs(); Frame F; frame_init(F, lds); mixC3_fast(F, kp, l, l == 0); SEAM(pb + 3); }
        if (IN(pb + 4)) { kptr_t kp = kargs(); unsigned char* ws = KWS();
            const int mrows = NLAT; const float* modl = (const float*)(ws + WS_MOD) + (size_t)l * 17 * 6144;
            pg8::Gemm g{(const bf16*)(ws + WS_RB), (const bf16*)(ws + WS_WOUT + l * WOUT_BYTES), mrows, DM, DM}; pg8::EvOrder S; S.init(mrows, DM, (int)gridDim.x, (int)blockIdx.x);
            S.ev = (const float*)(ws + WS_EV) + (size_t)(2 * l + 0) * 16 * 3 * 1024; S.pre = lds + PRE_OFF;
            pg8::EpiRes E{(const bf16*)(ws + WS_XN), (bf16*)(ws + WS_A2), 2 * l + 1, lds + PRE_OFF};
            pg8::gemm_phase<pg8::EpiRes, pg8::EvOrder, true, true>(lds, g, S, E);
            if (l != 0) SEAM(pb + 4);
        }
        if (IN(pb + 4) && l == 0) { kptr_t kp = kargs(); unsigned char* ws = KWS(); int tid_l = threadIdx.x; asm volatile("" : "+v"(tid_l));
            const float* modc = (const float*)(ws + WS_MOD) + (size_t)16 * 6144;
            const SmallRes R{(const bf16*)(ws + WS_XN), KIN(I_N1G), modc + 1 * 1024, (bf16*)(ws + WS_A2), KIN(I_N2G), modc + 4 * 1024, (float*)(ws + WS_RSQ) + (size_t)1 * MROWS, modc + 2 * 1024};
            __syncthreads();
            ctx_small_gemm(lds, tid_l, (const bf16*)(ws + WS_RB), (const bf16*)(ws + WS_WOUT), DM, R);
            SEAM(pb + 4);
        }
        if (IN(pb + 5)) { kptr_t kp = kargs(); unsigned char* ws = KWS();
            const int mrows = (l == 0) ? MROWS : NLAT;
            { Frame F; frame_init(F, lds); quant_rows_phase(F, kp, WS_A2, 2 * l + 1, mrows); }
            __syncthreads(); XBAR();
            pg8::Gemm g{(const bf16*)(ws + WS_RB), (const bf16*)(ws + WS_WQ + l * WQ_BYTES), mrows, 2 * DFF, DM / 2}; pg8::Pref3Order S; S.init(mrows, 2 * DFF, (int)gridDim.x, (int)blockIdx.x);
            S.rv = (const float*)(ws + WS_ROWFAC); S.cv = (const float*)(ws + WS_CV2) + (size_t)l * 17 * 5632; S.cvn = 5632; S.sv = (const float*)(ws + WS_SB) + (size_t)l * 5632; S.pre = lds + PRE_OFF;
            pg8::EpiSwiGLU8 E{(bf16*)(ws + WS_Z), lds + PRE_OFF};
            pg8::gemm_phase<pg8::EpiSwiGLU8, pg8::Pref3Order, true, true, 1>(lds, g, S, E);
            SEAM(pb + 5);
        }
        if (IN(pb + 6)) { kptr_t kp = kargs(); unsigned char* ws = KWS();
            const int mrows = NLAT; const float* modl = (const float*)(ws + WS_MOD) + (size_t)l * 17 * 6144;
            pg8::Gemm g{(const bf16*)(ws + WS_Z), (const bf16*)(ws + WS_W8DN + l * W8DN_BYTES), mrows, DM, DFF / 2}; pg8::EvOrder S; S.init(mrows, DM, (int)gridDim.x, (int)blockIdx.x);
            S.ev = (const float*)(ws + WS_EV) + (size_t)(2 * l + 1) * 16 * 3 * 1024; S.pre = lds + PRE_OFF;
            pg8::EpiRes E{(const bf16*)(ws + WS_A2), (bf16*)(ws + (l == 0 ? WS_XN : WS_RB)), 2 * l + 2, lds + PRE_OFF};
            pg8::gemm_phase<pg8::EpiRes, pg8::EvOrder, true, true, 2>(lds, g, S, E);
            if (l != 0) SEAM(pb + 6);
        }
        if (IN(pb + 6) && l == 0) { kptr_t kp = kargs(); unsigned char* ws = KWS(); int tid_l = threadIdx.x; asm volatile("" : "+v"(tid_l));
            const float* modc = (const float*)(ws + WS_MOD) + (size_t)16 * 6144;
            const SmallRes R{(const bf16*)(ws + WS_A2), KIN(I_N2G), modc + 4 * 1024, (bf16*)(ws + WS_XN), KIN(I_N1G) + DM, modc + (size_t)17 * 6144 + 1 * 1024, (float*)(ws + WS_RSQ) + (size_t)2 * MROWS, modc + 5 * 1024};
            __syncthreads();
            ctx_small_gemm(lds, tid_l, (const bf16*)(ws + WS_Z), (const bf16*)(ws + WS_WDN), DFF, R);
            SEAM(pb + 6);
        }
    }
    if (IN(16)) { kptr_t kp = kargs(); Frame F; frame_init(F, lds); final_norm_phase(F, kp); }
#undef IN
#undef SEAM
}

#ifndef MK_ONE_LAUNCH
#define MK_ONE_LAUNCH 1
#endif
extern "C" void kernel_launch(void* const* d_in, const int* in_sizes, int n_in, void* d_out, int out_size, void* d_ws, size_t ws_size, hipStream_t stream) {
    static int grid = 0;
    if (grid == 0) {
        if (n_in != 22 || out_size != NLAT * DM || ws_size < WS_TOTAL) { fprintf(stderr, "kernel_launch: unexpected problem (n_in %d, out %d, ws %zu < %zu); nothing launched\n", n_in, out_size, ws_size, (size_t)WS_TOTAL); grid = -1; return; }
        int dev = 0, cus = 0, per_cu = 0;
        if (hipGetDevice(&dev) != hipSuccess || hipDeviceGetAttribute(&cus, hipDeviceAttributeMultiprocessorCount, dev) != hipSuccess) { grid = -1; return; }
        if (hipFuncSetAttribute((const void*)fwd_kernel, hipFuncAttributeMaxDynamicSharedMemorySize, LDS_BYTES) != hipSuccess) { fprintf(stderr, "kernel_launch: hipFuncSetAttribute failed\n"); grid = -1; return; }
        if (hipOccupancyMaxActiveBlocksPerMultiprocessor(&per_cu, (const void*)fwd_kernel, NTHR, LDS_BYTES) != hipSuccess || per_cu < 1) { fprintf(stderr, "kernel_launch: occupancy query reports %d blocks per CU\n", per_cu); }
        (void)hipGetLastError();
        grid = cus;
    }
    if (grid < 0) return;
    (void)hipMemsetAsync((char*)d_ws + WS_CTL, 0, CTL_ZERO_BYTES, stream);
    Args a{};
    for (int i = 0; i < 22; ++i) a.in[i] = (const float*)d_in[i];
    a.out = (float*)d_out; a.ws = (unsigned char*)d_ws;
#if MK_ONE_LAUNCH
    a.ph_lo = 0; a.ph_hi = NPHASE;
    hipLaunchKernelGGL(fwd_kernel, dim3(grid), dim3(NTHR), LDS_BYTES, stream, a);
#else
    for (int p = 0; p < NPHASE; ++p) {
        a.ph_lo = p; a.ph_hi = p + 1;
        hipLaunchKernelGGL(fwd_kernel, dim3(grid), dim3(NTHR), LDS_BYTES, stream, a);
    }
#endif
}
```
